# Optimizing an MI355X kernel written in HIP

```python
import math
import jax, jax.numpy as jnp
from jax import lax
import numpy as np

D_MODEL = 2048
BATCH = 8
SEQ = 4096
DEPTH = 1

MIX_WIDTH = D_MODEL
HEAD_DIM = 128
RG_WIDTH = MIX_WIDTH // 2
RG_HEADS = RG_WIDTH // HEAD_DIM
CONV_WIDTH = 4
RG_C = 8.0
GM_WIDTH = MIX_WIDTH // 4
GM_GROUPS = GM_WIDTH // HEAD_DIM
CHUNK = 128
XA_WIDTH = MIX_WIDTH // 4
XA_HEADS = XA_WIDTH // HEAD_DIM
MEM_LEN = 256
IN_COLS = 2 * RG_WIDTH + 2 * GM_WIDTH + XA_WIDTH
N_EXPERTS = 32
TOP_K = 4
D_FF = D_MODEL
SWIGLU_LIMIT = 7.0
SWIGLU_ALPHA = 1.702
MOE_BLOCK = 512
EPS = 1e-6

kernel_name = "hybrid_rglru_gmlp_memxattn_moe"


def rms_norm(x, g):
    xf = x.astype(jnp.float32)
    y = xf * lax.rsqrt(jnp.mean(xf * xf, axis=-1, keepdims=True) + EPS)
    return (y * g.astype(jnp.float32)).astype(x.dtype)


def rglru_mixer(xr, gate, conv_w, conv_b, w_a, b_a, w_i, b_i, lam):
    B, T, _ = xr.shape
    xc = lax.conv_general_dilated(
        xr, conv_w[:, None, :], window_strides=(1,), padding=[(CONV_WIDTH - 1, 0)],
        dimension_numbers=("NWC", "WIO", "NWC"), feature_group_count=RG_WIDTH) + conv_b
    xb = xc.reshape(B, T, RG_HEADS, HEAD_DIM)
    r = jax.nn.sigmoid(jnp.einsum("bthi,hij->bthj", xb, w_a) + b_a).reshape(B, T, RG_WIDTH)
    i = jax.nn.sigmoid(jnp.einsum("bthi,hij->bthj", xb, w_i) + b_i).reshape(B, T, RG_WIDTH)
    log_a = -RG_C * r.astype(jnp.float32) * jax.nn.softplus(-lam.astype(jnp.float32))
    a = jnp.exp(log_a)
    mult = jnp.sqrt(-jnp.expm1(2.0 * log_a))
    u = mult * (i * xc).astype(jnp.float32)

    def combine(c1, c2):
        a1, b1 = c1
        a2, b2 = c2
        return a1 * a2, a2 * b1 + b2

    _, h = lax.associative_scan(combine, (a, u), axis=1)
    return jax.nn.gelu(gate) * h.astype(xr.dtype)


def gmlp_mixer(u, v, v_norm_g, w_s, b_s):
    B, T, _ = u.shape
    u = jax.nn.gelu(u)
    v = rms_norm(jax.nn.gelu(v), v_norm_g)
    vb = v.reshape(B, T // CHUNK, CHUNK, GM_GROUPS, HEAD_DIM)
    causal = jnp.tril(jnp.ones((CHUNK, CHUNK), dtype=w_s.dtype))
    w = w_s * causal[None]
    sv = jnp.einsum("gts,bcsgd->bctgd", w, vb) + b_s.T[None, None, :, :, None]
    return u * sv.reshape(B, T, GM_WIDTH)


def memory_xattn(q, mem_n, w_mk, w_mv):
    B, T, _ = q.shape
    M = mem_n.shape[1]
    k = (mem_n @ w_mk).reshape(B, M, XA_HEADS, HEAD_DIM)
    v = (mem_n @ w_mv).reshape(B, M, XA_HEADS, HEAD_DIM)
    qh = q.reshape(B, T, XA_HEADS, HEAD_DIM)
    s = jnp.einsum("bthd,bmhd->bhtm", qh, k).astype(jnp.float32) * (HEAD_DIM ** -0.5)
    p = jax.nn.softmax(s, axis=-1).astype(q.dtype)
    o = jnp.einsum("bhtm,bmhd->bthd", p, v)
    return o.reshape(B, T, XA_WIDTH)


def moe_ffn(xn, w_router, b_router, w_gate_up, b_gate_up, w_down, b_down):
    B, T, D = xn.shape
    N = B * T
    A = N * TOP_K
    xt = xn.reshape(N, D)
    logits = (xt @ w_router + b_router).astype(jnp.float32)
    top_vals, top_idx = lax.top_k(logits, TOP_K)
    gates = jax.nn.softmax(top_vals, axis=-1).astype(xn.dtype)

    per_expert = -(-A // N_EXPERTS)
    blk = min(MOE_BLOCK, max(8, 1 << (per_expert - 1).bit_length()))
    n_blocks = A // blk + N_EXPERTS
    flat_e = top_idx.reshape(-1)
    order = jnp.argsort(flat_e)
    sorted_e = flat_e[order]
    tok = order // TOP_K
    counts = jnp.bincount(flat_e, length=N_EXPERTS).astype(jnp.int32)
    grp_start = jnp.cumsum(counts) - counts
    padded = ((counts + blk - 1) // blk) * blk
    pad_end = jnp.cumsum(padded)
    pad_start = pad_end - padded
    dest = pad_start[sorted_e] + (jnp.arange(A, dtype=jnp.int32) - grp_start[sorted_e])
    block_expert = jnp.clip(
        jnp.searchsorted(pad_end, jnp.arange(n_blocks, dtype=jnp.int32) * blk, side="right"),
        0, N_EXPERTS - 1).astype(jnp.int32)
    xs_pad = jnp.zeros((n_blocks * blk, D), xn.dtype).at[dest].set(xt[tok])

    def expert_block(args):
        xb, e = args
        gu = xb @ w_gate_up[e] + b_gate_up[e]
        g = jnp.minimum(gu[:, 0::2], SWIGLU_LIMIT)
        up = jnp.clip(gu[:, 1::2], -SWIGLU_LIMIT, SWIGLU_LIMIT)
        act = (up + 1.0) * (g * jax.nn.sigmoid(SWIGLU_ALPHA * g))
        return act @ w_down[e] + b_down[e]

    ys_pad = lax.map(expert_block, (xs_pad.reshape(n_blocks, blk, D), block_expert))
    y_sorted = ys_pad.reshape(n_blocks * blk, D)[dest]
    y = jnp.zeros((A, D), xn.dtype).at[order].set(y_sorted).reshape(N, TOP_K, D)
    out = jnp.einsum("nkd,nk->nd", y, gates)
    return out.reshape(B, T, D)


def setup_inputs(seed: int = 0) -> dict:
    key = jax.random.key(seed)
    ks = jax.random.split(key, 32)
    f32 = jnp.float32
    L, D = DEPTH, D_MODEL

    def nrm(k, shape, scale):
        return jax.random.normal(k, shape, f32) * scale

    def gain(k, shape):
        return 1.0 + 0.02 * jax.random.normal(k, shape, f32)

    a_pow = jax.random.uniform(ks[10], (L, RG_WIDTH), f32, 0.9, 0.999)
    a_base = a_pow ** (1.0 / RG_C)
    lru_lambda = jnp.log(a_base) - jnp.log1p(-a_base)

    return {
        "x": jax.random.normal(ks[0], (BATCH, SEQ, D), f32),
        "mem": jax.random.normal(ks[1], (BATCH, MEM_LEN, D), f32),
        "ln_mix_g": gain(ks[2], (L, D)),
        "w_in": nrm(ks[3], (L, D, IN_COLS), D ** -0.5),
        "conv_w": nrm(ks[4], (L, CONV_WIDTH, RG_WIDTH), CONV_WIDTH ** -0.5),
        "conv_b": nrm(ks[5], (L, RG_WIDTH), 0.01),
        "w_rg_a": nrm(ks[6], (L, RG_HEADS, HEAD_DIM, HEAD_DIM), HEAD_DIM ** -0.5),
        "b_rg_a": nrm(ks[7], (L, RG_HEADS, HEAD_DIM), 0.01),
        "w_rg_i": nrm(ks[8], (L, RG_HEADS, HEAD_DIM, HEAD_DIM), HEAD_DIM ** -0.5),
        "b_rg_i": nrm(ks[9], (L, RG_HEADS, HEAD_DIM), 0.01),
        "lru_lambda": lru_lambda,
        "gm_v_norm_g": gain(ks[11], (L, GM_WIDTH)),
        "w_spatial": nrm(ks[12], (L, GM_GROUPS, CHUNK, CHUNK), CHUNK ** -0.5),
        "b_spatial": gain(ks[13], (L, GM_GROUPS, CHUNK)),
        "mem_norm_g": gain(ks[14], (L, D)),
        "w_mem_k": nrm(ks[15], (L, D, XA_WIDTH), D ** -0.5),
        "w_mem_v": nrm(ks[16], (L, D, XA_WIDTH), D ** -0.5),
        "out_norm_g": gain(ks[17], (L, MIX_WIDTH)),
        "w_out": nrm(ks[18], (L, MIX_WIDTH, D), MIX_WIDTH ** -0.5),
        "ln_ffn_g": gain(ks[19], (L, D)),
        "w_router": nrm(ks[20], (L, D, N_EXPERTS), D ** -0.5),
        "b_router": nrm(ks[21], (L, N_EXPERTS), 0.01),
        "w_gate_up": nrm(ks[22], (L, N_EXPERTS, D, 2 * D_FF), D ** -0.5),
        "b_gate_up": nrm(ks[23], (L, N_EXPERTS, 2 * D_FF), 0.01),
        "w_down": nrm(ks[24], (L, N_EXPERTS, D_FF, D), D_FF ** -0.5),
        "b_down": nrm(ks[25], (L, N_EXPERTS, D), 0.01),
        "final_norm_g": gain(ks[26], (D,)),
    }


def reference(x, mem, ln_mix_g, w_in, conv_w, conv_b, w_rg_a, b_rg_a, w_rg_i, b_rg_i,
              lru_lambda, gm_v_norm_g, w_spatial, b_spatial, mem_norm_g, w_mem_k, w_mem_v,
              out_norm_g, w_out, ln_ffn_g, w_router, b_router, w_gate_up, b_gate_up,
              w_down, b_down, final_norm_g):
    h = x
    c1 = RG_WIDTH
    c2 = 2 * RG_WIDTH
    c3 = c2 + GM_WIDTH
    c4 = c3 + GM_WIDTH
    for l in range(DEPTH):
        xn = rms_norm(h, ln_mix_g[l])
        p = xn @ w_in[l]
        y_rg = rglru_mixer(p[..., :c1], p[..., c1:c2], conv_w[l], conv_b[l],
                           w_rg_a[l], b_rg_a[l], w_rg_i[l], b_rg_i[l], lru_lambda[l])
        y_gm = gmlp_mixer(p[..., c2:c3], p[..., c3:c4], gm_v_norm_g[l], w_spatial[l], b_spatial[l])
        mem_n = rms_norm(mem, mem_norm_g[l])
        y_xa = memory_xattn(p[..., c4:], mem_n, w_mem_k[l], w_mem_v[l])
        g = out_norm_g[l]
        y = jnp.concatenate([
            rms_norm(y_rg, g[:RG_WIDTH]),
            rms_norm(y_gm, g[RG_WIDTH:RG_WIDTH + GM_WIDTH]),
            rms_norm(y_xa, g[RG_WIDTH + GM_WIDTH:]),
        ], axis=-1)
        h = h + y @ w_out[l]
        hn = rms_norm(h, ln_ffn_g[l])
        h = h + moe_ffn(hn, w_router[l], b_router[l], w_gate_up[l], b_gate_up[l],
                        w_down[l], b_down[l])
    return rms_norm(h, final_norm_g)
```

```cpp
#include <hip/hip_runtime.h>
#include <cstdio>
#include <cstdint>

#ifndef REP_PHASE
#define REP_PHASE -1
#endif
#ifndef MK_ONE_LAUNCH
#define MK_ONE_LAUNCH 1
#endif

#define GAS __attribute__((address_space(1)))
#define LAS __attribute__((address_space(3)))
typedef unsigned short bf16;
typedef unsigned v4u __attribute__((ext_vector_type(4)));
typedef unsigned v2u __attribute__((ext_vector_type(2)));
typedef float f32x4 __attribute__((ext_vector_type(4)));
typedef float f32x2 __attribute__((ext_vector_type(2)));
typedef float f32x16 __attribute__((ext_vector_type(16)));
typedef short bf16x8 __attribute__((ext_vector_type(8)));
typedef int i32x4 __attribute__((ext_vector_type(4)));
typedef int i32x8 __attribute__((ext_vector_type(8)));
typedef int i32x6 __attribute__((ext_vector_type(6)));
typedef unsigned u32x6 __attribute__((ext_vector_type(6)));

constexpr int D = 2048, NB = 8, T = 4096, NTOK = NB * T;
constexpr int INC = 3584, RGW = 1024, GMW = 512, XAW = 512, HD = 128;
constexpr int NE = 32, TOPK = 4, MEM = 256;
constexpr int NASSIGN = NTOK * TOPK;
constexpr int MAXROWS = NASSIGN + NE * 256;
constexpr float EPS = 1e-6f;
constexpr int NCHUNK = T / 128;

constexpr size_t MiB = 1u << 20;
constexpr size_t WS_CTL = 0, CTL_ZERO_BYTES = 1 * MiB;
constexpr size_t CTL_SS = 128 * 1024;
constexpr float SS_SCALE = 1048576.0f, SS_INV = 1.0f / 1048576.0f;
constexpr size_t WS_WIN = 1 * MiB;
constexpr size_t WS_WOUT = 16 * MiB;
constexpr size_t WS_WKT = 24 * MiB;
constexpr size_t WS_WVT = 26 * MiB;
constexpr size_t WS_WA = 28 * MiB;
constexpr size_t WS_WI = WS_WA + 256 * 1024;
constexpr size_t WS_WSP = WS_WI + 256 * 1024;
constexpr size_t WS_WRP = WS_WSP + 128 * 1024;
constexpr size_t WS_MEMN = 30 * MiB;
constexpr size_t WS_KB = 38 * MiB;
constexpr size_t WS_VT = 40 * MiB;
constexpr size_t WS_CARRY = 42 * MiB;
constexpr size_t WS_TOPI = 44 * MiB;
constexpr size_t WS_TOPG = WS_TOPI + 512 * 1024;
constexpr size_t WS_INV = WS_TOPG + 512 * 1024;
constexpr size_t WS_CNTWG = WS_INV + 512 * 1024;
constexpr size_t WS_META = WS_CNTWG + 128 * 1024;
constexpr size_t WS_RSTD = WS_META + 4096;
constexpr size_t WS_RSS = 49 * MiB;
constexpr size_t WS_TOKS = 46 * MiB;
constexpr size_t WS_GATES = 47 * MiB;
constexpr size_t WS_DUMMY = 48 * MiB;
constexpr size_t WS_GRAN = 50 * MiB;
constexpr size_t WS_RSTD0 = 56 * MiB;
constexpr size_t WS_XB = 64 * MiB;
constexpr size_t WS_P = 192 * MiB;
constexpr size_t WS_YBUF = 416 * MiB;
constexpr size_t WS_H = 544 * MiB;
constexpr size_t WS_HN = 800 * MiB;
constexpr size_t WS_WGU = 1024 * MiB;
constexpr size_t WS_WD = 1536 * MiB;
constexpr size_t WS_ACT = 1792 * MiB;
constexpr size_t WS_YS = 2336 * MiB;
constexpr size_t WS_KVP = 2880 * MiB;
constexpr size_t WS_END = 2944 * MiB;
constexpr int CW_BAR = 4096;

constexpr int LDS_BYTES = 163840;
constexpr int LDSCTL_OFF = 162816;
constexpr int LC_BAR = 0;
constexpr int LC_TPRE = 8;
constexpr int LC_HIST = 48;
constexpr int LC_BASE = 80;
constexpr int LC_TOTAL = 112;
constexpr int LC_PTR = 160;

#define LDS_WAIT() asm volatile("s_waitcnt lgkmcnt(0)" ::: "memory")
#define VM_WAIT() asm volatile("s_waitcnt vmcnt(0)" ::: "memory")

__device__ __forceinline__ unsigned f2bf(float f) { unsigned u = __builtin_bit_cast(unsigned, f); return (u + 0x7fffu + ((u >> 16) & 1u)) >> 16; }
__device__ __forceinline__ unsigned pk2(float lo, float hi) { return f2bf(lo) | (f2bf(hi) << 16); }
__device__ __forceinline__ float bflo(unsigned w) { return __builtin_bit_cast(float, w << 16); }
__device__ __forceinline__ float bfhi(unsigned w) { return __builtin_bit_cast(float, w & 0xffff0000u); }
__device__ __forceinline__ float bf2f(bf16 b) { return __builtin_bit_cast(float, (unsigned)b << 16); }
__device__ __forceinline__ unsigned pk4_fp8(float a, float b, float c, float d) {
    a = fminf(fmaxf(a, -448.f), 448.f); b = fminf(fmaxf(b, -448.f), 448.f); c = fminf(fmaxf(c, -448.f), 448.f); d = fminf(fmaxf(d, -448.f), 448.f);
    int r = __builtin_amdgcn_cvt_pk_fp8_f32(a, b, 0, false);
    r = __builtin_amdgcn_cvt_pk_fp8_f32(c, d, r, true);
    return (unsigned)r;
}
__device__ __forceinline__ unsigned pk4_fp8_sc(float a, float b, float c, float d) {
    a = __builtin_amdgcn_fmed3f(a, -448.f, 448.f); b = __builtin_amdgcn_fmed3f(b, -448.f, 448.f); c = __builtin_amdgcn_fmed3f(c, -448.f, 448.f); d = __builtin_amdgcn_fmed3f(d, -448.f, 448.f);
    int r = __builtin_amdgcn_cvt_pk_fp8_f32(a, b, 0, false);
    r = __builtin_amdgcn_cvt_pk_fp8_f32(c, d, r, true);
    return (unsigned)r;
}
__device__ __forceinline__ void pack_fp6(const float (&v)[32], v4u& lo, v4u& hi) {
    float am = 0.f;
#pragma unroll
    for (int e = 0; e < 32; ++e) am = fmaxf(am, __builtin_fabsf(v[e]));
    unsigned eb = (__builtin_bit_cast(unsigned, am) >> 23) & 0xffu; eb = eb < 3u ? 3u : (eb > 250u ? 250u : eb);
    const unsigned sb = eb - 2u;
    const float inv = __builtin_bit_cast(float, (254u - sb) << 23);
    f32x16 a, b;
#pragma unroll
    for (int e = 0; e < 16; ++e) { a[e] = v[e] * inv; b[e] = v[16 + e] * inv; }
    const u32x6 d = __builtin_amdgcn_cvt_scalef32_2xpk16_fp6_f32(a, b, 1.0f);
    lo = (v4u){d[0], d[1], d[2], d[3]}; hi = (v4u){d[4], d[5], sb, 0u};
}
__device__ __forceinline__ int lane_id() { int l; asm volatile("v_mbcnt_lo_u32_b32 %0, -1, 0\n\tv_mbcnt_hi_u32_b32 %0, -1, %0" : "=v"(l)); return l; }
__device__ __forceinline__ float wave_sum(float v) {
#pragma unroll
    for (int o = 1; o < 64; o <<= 1) v += __shfl_xor(v, o);
    return v;
}
__device__ __forceinline__ float fast_exp2(float x) { return __builtin_amdgcn_exp2f(x); }
__device__ __forceinline__ float fast_rcp(float x) { return __builtin_amdgcn_rcpf(x); }
__device__ __forceinline__ float sigmoidf_(float z) { return fast_rcp(1.0f + fast_exp2(-1.4426950409f * z)); }
__device__ __forceinline__ float gelu_tanh(float x) { const float u = x + 0.044715f * x * x * x; return x * fast_rcp(1.0f + fast_exp2(-2.3022082f * u)); }

#define XB_TMO      128
#define XB_XCNT(j)  (256  + 64 * (j))
#define XB_XSUB(j)  (1280 + 64 * (j))
#define XB_XGEN(j)  (2304 + 64 * (j))
#define XB_TOP      3328
#define XB_TOPGEN   3392
#define XCD_BAR_WORDS 3456
#define XB_SPIN_CAP (1u << 18)
__device__ __forceinline__ unsigned xb_ld(unsigned* p)              { return __hip_atomic_load(p, __ATOMIC_RELAXED, __HIP_MEMORY_SCOPE_AGENT); }
__device__ __forceinline__ unsigned xb_add(unsigned* p, unsigned v) { return __hip_atomic_fetch_add(p, v, __ATOMIC_RELAXED, __HIP_MEMORY_SCOPE_AGENT); }
__device__ __forceinline__ unsigned xb_xcc_id() { return (unsigned)__builtin_amdgcn_s_getreg((3 << 11) | 20) & 0xFu; }
#define XB_SPIN(cond, bar) do { unsigned _sp = 0; while (cond) { __builtin_amdgcn_s_sleep(1); \
    if ((++_sp & 255u) == 0u) { if (xb_ld(&(bar)[XB_TMO])) break; if (_sp > XB_SPIN_CAP) { atomicAdd(&(bar)[XB_TMO], 1u); break; } } } } while (0)
struct XcdBarrier { unsigned* bar; unsigned x; volatile LAS unsigned* st; int wave; };
__device__ __forceinline__ XcdBarrier xcd_barrier_post(unsigned* bar, volatile LAS unsigned* st, int wave) {
    XcdBarrier b; b.bar = bar; b.x = xb_xcc_id(); b.st = st; b.wave = wave;
    if (wave == 0 && lane_id() == 0) (void)xb_add(&bar[XB_XCNT(b.x)], 1u);
    return b;
}
__device__ __forceinline__ void xcd_barrier_complete(unsigned* bar, unsigned x, unsigned& nloc, unsigned& nx) {
    const unsigned G = gridDim.x * gridDim.y * gridDim.z;
    unsigned sum, cnt, mine, sp = 0u;
    for (;;) {
        sum = 0u; cnt = 0u; mine = 0u;
#pragma unroll
        for (unsigned j = 0; j < 16; ++j) { const unsigned c = xb_ld(&bar[XB_XCNT(j)]); sum += c; cnt += (c > 0u) ? 1u : 0u; mine = (j == x) ? c : mine; }
        if (sum == G) break;
        __builtin_amdgcn_s_sleep(1);
        if ((++sp & 255u) == 0u) { if (xb_ld(&bar[XB_TMO])) break; if (sp > XB_SPIN_CAP) { atomicAdd(&bar[XB_TMO], 1u); break; } }
    }
    nloc = mine > 0u ? mine : 1u; nx = cnt > 0u ? cnt : 1u;
}
__device__ __forceinline__ void xcd_barrier(const XcdBarrier& b) {
    asm volatile("s_waitcnt vmcnt(0)" ::: "memory");
    __syncthreads();
    if (b.wave == 0 && lane_id() == 0) {
        unsigned* bar = b.bar;
        __builtin_amdgcn_s_waitcnt(0);
        unsigned nloc = b.st[0], nx = b.st[1];
        if (nloc == 0u) { xcd_barrier_complete(bar, b.x, nloc, nx); b.st[0] = nloc; b.st[1] = nx; }
        const unsigned old = xb_add(&bar[XB_XSUB(b.x)], 1u);
        const unsigned gen = old / nloc;
        if (old + 1u == (gen + 1u) * nloc) {
            __builtin_amdgcn_fence(__ATOMIC_RELEASE, "agent");
            asm volatile("s_waitcnt vmcnt(0)" ::: "memory");
            const unsigned og = xb_add(&bar[XB_TOP], 1u);
            const unsigned tg = og / nx;
            if (og + 1u == (tg + 1u) * nx) xb_add(&bar[XB_TOPGEN], 1u);
            else XB_SPIN(xb_ld(&bar[XB_TOPGEN]) == tg, bar);
            __builtin_amdgcn_fence(__ATOMIC_ACQUIRE, "agent");
            xb_add(&bar[XB_XGEN(b.x)], 1u);
            asm volatile("s_waitcnt vmcnt(0)" ::: "memory");
        } else {
            XB_SPIN(xb_ld(&bar[XB_XGEN(b.x)]) == gen, bar);
            __builtin_amdgcn_fence(__ATOMIC_ACQUIRE, "agent");
            asm volatile("s_waitcnt vmcnt(0)" ::: "memory");
        }
    }
    __syncthreads();
}

namespace pg8 {
constexpr int BM = 256, BK = 64, HALF = 128, HTB = HALF * BK * 2, STAGE_BYTES = 8 * HTB, NXCD = 8, WGM = 8;
constexpr int K = 2048;
__host__ __device__ __forceinline__ int lds_byte(int r, int c) { const int st = (r >> 4) * 2 + (c >> 5), rr = r & 15, cc = c & 31, ob = rr * 64 + cc * 2; return st * 1024 + (ob ^ (((ob >> 9) & 1) << 5)); }
__host__ __device__ __forceinline__ void stage_rc(int b, int& R, int& C) { const int st = b / 1024, sb = b % 1024, swz = sb ^ (((sb >> 9) & 1) << 5); R = (st >> 1) * 16 + swz / 64; C = (st & 1) * 32 + (swz % 64) / 2; }
__host__ __device__ __forceinline__ int perm32(int rho) { const int n = rho >> 4, i = rho & 15; return 8 * (i >> 2) + 4 * n + (i & 3); }

struct Unit { int pm, pn, e; };

__device__ __forceinline__ bool tile_order(int i, int G, int c, int nM, int nN, int& pm, int& pn) {
    const int nwg = nM * nN; const long L = (long)i * G + c; if (L >= nwg) return false;
    int wgid = (int)L; { const int q = nwg / NXCD, r = nwg % NXCD, xcd = wgid % NXCD, off = wgid / NXCD; wgid = (xcd < r ? xcd * (q + 1) : r * (q + 1) + (xcd - r) * q) + off; }
    const int nig = WGM * nN, gid = wgid / nig, fm = gid * WGM, gsz = (nM - fm) < WGM ? (nM - fm) : WGM;
    pm = fm + ((wgid % nig) % gsz); pn = (wgid % nig) / gsz; return true;
}
struct DenseOrder {
    static constexpr int KB = K * 2;
    int nM, nN, G, c; const bf16* Bt;
    __device__ __forceinline__ void init(int M, int N, int G_, int c_, const bf16* Bt_) { nM = M / BM; nN = N / BM; G = G_; c = c_; Bt = Bt_; }
    __device__ __forceinline__ bool next(int i, Unit& u) const { u.e = i; return tile_order(i, G, c, nM, nN, u.pm, u.pn); }
    __device__ __forceinline__ unsigned arow(const Unit& u, int r) const { return (unsigned)(u.pm * BM + r) * (unsigned)(K * 2); }
    __device__ __forceinline__ const char* bptr(const Unit& u) const { return (const char*)Bt + (size_t)u.pn * BM * K * 2; }
};
struct DenseSplit8 {
    static constexpr int KB = K * 2;
    int nM, nN, G, c; const bf16* Bt;
    __device__ __forceinline__ void init(int M, int N, int G_, int c_, const bf16* Bt_) { nM = M / BM; nN = N / BM; G = G_; c = c_; Bt = Bt_; }
    __device__ __forceinline__ bool next(int i, Unit& u) const { const long L = (long)i * G + c; if (L >= (long)nM * nN * 8) return false; const int t = (int)(L >> 3); u.e = (int)(L & 7); u.pm = t / nN; u.pn = t % nN; return true; }
    __device__ __forceinline__ unsigned arow(const Unit& u, int r) const { return (unsigned)(u.pm * BM + r) * (unsigned)KB + (unsigned)u.e * 512u; }
    __device__ __forceinline__ const char* bptr(const Unit& u) const { return (const char*)Bt + (size_t)u.pn * BM * KB + (size_t)u.e * 512; }
};
template <bool GATHER> struct GroupedOrder {
    static constexpr int KB = K;
    int nM, nN, G, c; const void* Bt; const int* tok; const volatile LAS int* tpre;
    __device__ __forceinline__ bool next(int i, Unit& u) const {
        if (!tile_order(i, G, c, nM, nN, u.pm, u.pn)) return false;
        int e = 0;
        for (int j = 1; j < NE; ++j) e += (tpre[j] <= u.pm) ? 1 : 0;
        u.e = __builtin_amdgcn_readfirstlane(e); return true;
    }
    __device__ __forceinline__ unsigned arow(const Unit& u, int r) const {
        if (GATHER) return (unsigned)tok[u.pm * BM + r] * (unsigned)KB;
        return (unsigned)(u.pm * BM + r) * (unsigned)KB;
    }
    __device__ __forceinline__ const char* bptr(const Unit& u) const { return (const char*)Bt + ((size_t)u.e * nN + u.pn) * (size_t)BM * KB; }
};

__device__ __forceinline__ unsigned cvt_pk_bf16(float lo, float hi) { unsigned r; asm volatile("v_cvt_pk_bf16_f32 %0, %1, %2" : "=v"(r) : "v"(lo), "v"(hi)); return r; }

struct EpiInProj {
    static constexpr bool PERM = true, KSEG = false;
    bf16* O; float qscale; const LAS float* rs;
    __device__ __forceinline__ void kseg(f32x4 (&)[2][2][4][2], const Unit&, int, int, int) const {}
    __device__ __forceinline__ void operator()(const f32x4 (&acc)[2][2][4][2], const Unit& u, int wr, int wc, int fr, int fq) const {
        const int row0 = u.pm * BM + wr * 64 + fr, col0 = u.pn * BM + wc * 32 + 8 * fq;
        const int mode = (u.pn >= 4 && u.pn < 12) ? 1 : (u.pn >= 12 ? 2 : 0);
        float rrv[2][4];
#pragma unroll
        for (int ai = 0; ai < 2; ++ai)
#pragma unroll
            for (int m = 0; m < 4; ++m) rrv[ai][m] = rs[u.e * BM + wr * 64 + fr + ai * HALF + m * 16];
        asm volatile("" : "+v"(rrv[0][0]), "+v"(rrv[0][1]), "+v"(rrv[0][2]), "+v"(rrv[0][3]), "+v"(rrv[1][0]), "+v"(rrv[1][1]), "+v"(rrv[1][2]), "+v"(rrv[1][3]));
#pragma unroll
        for (int ai = 0; ai < 2; ++ai)
#pragma unroll
            for (int m = 0; m < 4; ++m) { bf16* rowp = O + (size_t)(row0 + ai * HALF + m * 16) * INC + col0; const float rr = (mode == 2) ? rrv[ai][m] * qscale : rrv[ai][m];
#pragma unroll
                for (int bj = 0; bj < 2; ++bj) { f32x4 v0 = acc[ai][bj][m][0] * rr, v1 = acc[ai][bj][m][1] * rr;
                    if (mode == 1) {
#pragma unroll
                        for (int j = 0; j < 4; ++j) { v0[j] = gelu_tanh(v0[j]); v1[j] = gelu_tanh(v1[j]); } }
                    v4u w; w.x = cvt_pk_bf16(v0[0], v0[1]); w.y = cvt_pk_bf16(v0[2], v0[3]); w.z = cvt_pk_bf16(v1[0], v1[1]); w.w = cvt_pk_bf16(v1[2], v1[3]);
                    *(v4u*)(rowp + bj * HALF) = w; } }
    }
};
struct EpiPlainBf16 {
    static constexpr bool PERM = true, KSEG = false;
    bf16* O; int ldc;
    __device__ __forceinline__ void kseg(f32x4 (&)[2][2][4][2], const Unit&, int, int, int) const {}
    __device__ __forceinline__ void operator()(const f32x4 (&acc)[2][2][4][2], const Unit& u, int wr, int wc, int fr, int fq) const {
        const int row0 = u.pm * BM + wr * 64 + fr, col0 = u.pn * BM + wc * 32 + 8 * fq;
#pragma unroll
        for (int ai = 0; ai < 2; ++ai)
#pragma unroll
            for (int m = 0; m < 4; ++m) { bf16* rowp = O + (size_t)(row0 + ai * HALF + m * 16) * ldc + col0;
#pragma unroll
                for (int bj = 0; bj < 2; ++bj) { const f32x4 v0 = acc[ai][bj][m][0], v1 = acc[ai][bj][m][1];
                    v4u w; w.x = cvt_pk_bf16(v0[0], v0[1]); w.y = cvt_pk_bf16(v0[2], v0[3]); w.z = cvt_pk_bf16(v1[0], v1[1]); w.w = cvt_pk_bf16(v1[2], v1[3]);
                    *(v4u*)(rowp + bj * HALF) = w; } }
    }
};
struct EpiPartialF32 {
    static constexpr bool PERM = false, KSEG = false;
    bf16* O; int ldc; size_t slice_stride;
    __device__ __forceinline__ void kseg(f32x4 (&)[2][2][4][2], const Unit&, int, int, int) const {}
    __device__ __forceinline__ void operator()(const f32x4 (&acc)[2][2][4][2], const Unit& u, int wr, int wc, int fr, int fq) const {
        const int row0 = u.pm * BM + wr * 64 + fr, col0 = u.pn * BM + wc * 32 + 4 * fq; bf16* base = O + (size_t)u.e * slice_stride;
#pragma unroll
        for (int ai = 0; ai < 2; ++ai)
#pragma unroll
            for (int m = 0; m < 4; ++m) { bf16* rowp = base + (size_t)(row0 + ai * HALF + m * 16) * ldc + col0;
#pragma unroll
                for (int bj = 0; bj < 2; ++bj)
#pragma unroll
                    for (int n = 0; n < 2; ++n) { const f32x4 a = acc[ai][bj][m][n]; v2u w; w.x = cvt_pk_bf16(a[0], a[1]); w.y = cvt_pk_bf16(a[2], a[3]); *(v2u*)(rowp + bj * HALF + n * 16) = w; } }
    }
};
struct EpiOutProj {
    static constexpr bool PERM = true, KSEG = true;
    const bf16* X; bf16* Hout; const unsigned long long* ss;
    const LAS float* fac;
    __device__ __forceinline__ void kseg(f32x4 (&acc)[2][2][4][2], const Unit& u, int t, int wr, int fr) const {
#pragma unroll
        for (int ai = 0; ai < 2; ++ai)
#pragma unroll
            for (int m = 0; m < 4; ++m) {
                const float s = fac[(u.e * BM + wr * 64 + fr + ai * HALF + m * 16) * 3 + (t == 16 ? 0 : 1)];
#pragma unroll
                for (int bj = 0; bj < 2; ++bj)
#pragma unroll
                    for (int n = 0; n < 2; ++n) acc[ai][bj][m][n] = acc[ai][bj][m][n] * s; }
    }
    __device__ __forceinline__ void operator()(const f32x4 (&acc)[2][2][4][2], const Unit& u, int wr, int wc, int fr, int fq) const {
        const int row0 = u.pm * BM + wr * 64 + fr, col0 = u.pn * BM + wc * 32 + 8 * fq;
#pragma unroll
        for (int ai = 0; ai < 2; ++ai)
#pragma unroll
          for (int mp = 0; mp < 2; ++mp) {
            v4u xv[2][2]; float svf[2];
#pragma unroll
            for (int mm = 0; mm < 2; ++mm) svf[mm] = (float)ss[2 * NTOK + row0 + ai * HALF + (2 * mp + mm) * 16];
#pragma unroll
            for (int mm = 0; mm < 2; ++mm)
#pragma unroll
                for (int bj = 0; bj < 2; ++bj) xv[mm][bj] = *(const v4u*)(X + (size_t)(row0 + ai * HALF + (2 * mp + mm) * 16) * D + col0 + bj * HALF);
#pragma unroll
            for (int mm = 0; mm < 2; ++mm) asm volatile("" : "+v"(xv[mm][0]), "+v"(xv[mm][1]));
#pragma unroll
            for (int mm = 0; mm < 2; ++mm) { const int m = 2 * mp + mm; const int r = row0 + ai * HALF + m * 16; const size_t off = (size_t)r * D + col0;
                const float s = 1.0f / __builtin_sqrtf(svf[mm] * (SS_INV / XAW) + EPS);
#pragma unroll
                for (int bj = 0; bj < 2; ++bj) { const v4u xq = xv[mm][bj];
                    const f32x4 h0 = (f32x4){bflo(xq.x), bfhi(xq.x), bflo(xq.y), bfhi(xq.y)} + acc[ai][bj][m][0] * s, h1 = (f32x4){bflo(xq.z), bfhi(xq.z), bflo(xq.w), bfhi(xq.w)} + acc[ai][bj][m][1] * s;
                    v4u w; w.x = cvt_pk_bf16(h0[0], h0[1]); w.y = cvt_pk_bf16(h0[2], h0[3]); w.z = cvt_pk_bf16(h1[0], h1[1]); w.w = cvt_pk_bf16(h1[2], h1[3]);
                    *(v4u*)(Hout + off + bj * HALF) = w; } } }
    }
};
struct EpiGateUp {
    static constexpr bool PERM = true, KSEG = false;
    unsigned char* O; const float* bias; const float* rs; LAS unsigned char* stg;
    static constexpr int SST = 144;
    __device__ __forceinline__ void kseg(f32x4 (&)[2][2][4][2], const Unit&, int, int, int) const {}
    __device__ __forceinline__ void operator()(const f32x4 (&acc)[2][2][4][2], const Unit& u, int wr, int wc, int fr, int fq) const {
        const int row0 = u.pm * BM + wr * 64 + fr, col0 = u.pn * BM + wc * 32 + 8 * fq;
        const float* bp = bias + (size_t)u.e * 4096 + col0;
        f32x4 bv[2][2];
#pragma unroll
        for (int bj = 0; bj < 2; ++bj)
#pragma unroll
            for (int n = 0; n < 2; ++n) bv[bj][n] = *(const f32x4*)(bp + bj * HALF + 4 * n);
        float rrv[2][4];
#pragma unroll
        for (int ai = 0; ai < 2; ++ai)
#pragma unroll
            for (int m = 0; m < 4; ++m) rrv[ai][m] = rs[row0 + ai * HALF + m * 16];
        asm volatile("" : "+v"(rrv[0][0]), "+v"(rrv[0][1]), "+v"(rrv[0][2]), "+v"(rrv[0][3]), "+v"(rrv[1][0]), "+v"(rrv[1][1]), "+v"(rrv[1][2]), "+v"(rrv[1][3]));
        const int tid = (wr * 4 + wc) * 64 + fq * 16 + fr;
#pragma unroll
        for (int ai = 0; ai < 2; ++ai) {
#pragma unroll
            for (int m = 0; m < 4; ++m) { const float rr = rrv[ai][m]; LAS unsigned char* rowp = stg + (wr * 64 + m * 16 + fr) * SST + wc * 16 + 4 * fq;
#pragma unroll
                for (int bj = 0; bj < 2; ++bj) { const f32x4 v0 = acc[ai][bj][m][0] * rr + bv[bj][0], v1 = acc[ai][bj][m][1] * rr + bv[bj][1];
                    float a[4];
                    const float gg[4] = {v0[0], v0[2], v1[0], v1[2]}, uu[4] = {v0[1], v0[3], v1[1], v1[3]};
#pragma unroll
                    for (int j = 0; j < 4; ++j) { const float g = fminf(gg[j], 7.0f), up = fminf(fmaxf(uu[j], -7.0f), 7.0f);
                        const float glu = g * fast_rcp(1.0f + fast_exp2(-1.702f * 1.4426950409f * g)); a[j] = __builtin_fmaf(up, glu, glu); }
                    int pw = __builtin_amdgcn_cvt_pk_fp8_f32(a[0], a[1], 0, false); pw = __builtin_amdgcn_cvt_pk_fp8_f32(a[2], a[3], pw, true);
                    *(LAS unsigned*)(rowp + bj * (HALF / 2)) = (unsigned)pw; } }
            asm volatile("s_waitcnt lgkmcnt(0)" ::: "memory"); __builtin_amdgcn_s_barrier(); asm volatile("" ::: "memory");
#pragma unroll
            for (int p = 0; p < 2; ++p) { const int idx = tid + 512 * p, row = idx >> 3, ch = idx & 7;
                const v4u d = *(const LAS v4u*)(stg + row * SST + 16 * ch);
                *(v4u*)(O + (size_t)(u.pm * BM + ai * HALF + row) * 2048 + u.pn * 128 + 16 * ch) = d; }
            if (ai == 0) { asm volatile("s_waitcnt lgkmcnt(0)" ::: "memory"); __builtin_amdgcn_s_barrier(); asm volatile("" ::: "memory"); }
        }
    }
};
struct EpiDown {
    static constexpr bool PERM = true, KSEG = false;
    unsigned char* O; const float* bias; const float* gate; LAS unsigned char* stg;
    static constexpr int SST = 144;
    __device__ __forceinline__ void kseg(f32x4 (&)[2][2][4][2], const Unit&, int, int, int) const {}
    __device__ __forceinline__ void operator()(const f32x4 (&acc)[2][2][4][2], const Unit& u, int wr, int wc, int fr, int fq) const {
        const int row0 = u.pm * BM + wr * 64 + fr, col0 = u.pn * BM + wc * 32 + 8 * fq;
        const float* bp = bias + (size_t)u.e * 2048 + col0;
        f32x4 bv[2][2];
#pragma unroll
        for (int bj = 0; bj < 2; ++bj)
#pragma unroll
            for (int n = 0; n < 2; ++n) bv[bj][n] = *(const f32x4*)(bp + bj * HALF + 4 * n);
        float gtv[2][4];
#pragma unroll
        for (int ai = 0; ai < 2; ++ai)
#pragma unroll
            for (int m = 0; m < 4; ++m) gtv[ai][m] = gate[row0 + ai * HALF + m * 16];
        asm volatile("" : "+v"(gtv[0][0]), "+v"(gtv[0][1]), "+v"(gtv[0][2]), "+v"(gtv[0][3]), "+v"(gtv[1][0]), "+v"(gtv[1][1]), "+v"(gtv[1][2]), "+v"(gtv[1][3]));
        const int tid = (wr * 4 + wc) * 64 + fq * 16 + fr;
#pragma unroll
        for (int ai = 0; ai < 2; ++ai)
#pragma unroll
            for (int bj = 0; bj < 2; ++bj) {
#pragma unroll
                for (int m = 0; m < 4; ++m) { const float gt = gtv[ai][m] * 16.0f;
                    const f32x4 v0 = (acc[ai][bj][m][0] + bv[bj][0]) * gt, v1 = (acc[ai][bj][m][1] + bv[bj][1]) * gt;
                    v2u w; w.x = pk4_fp8_sc(v0[0], v0[1], v0[2], v0[3]); w.y = pk4_fp8_sc(v1[0], v1[1], v1[2], v1[3]);
                    *(LAS v2u*)(stg + (wr * 64 + m * 16 + fr) * SST + wc * 32 + 8 * fq) = w; }
                asm volatile("s_waitcnt lgkmcnt(0)" ::: "memory"); __builtin_amdgcn_s_barrier(); asm volatile("" ::: "memory");
#pragma unroll
                for (int p = 0; p < 2; ++p) { const int idx = tid + 512 * p, row = idx >> 3, ch = idx & 7;
                    const v4u d = *(const LAS v4u*)(stg + row * SST + 16 * ch);
                    *(v4u*)(O + (size_t)(u.pm * BM + ai * HALF + row) * 2048 + u.pn * BM + bj * HALF + 16 * ch) = d; }
                if (ai == 0 || bj == 0) { asm volatile("s_waitcnt lgkmcnt(0)" ::: "memory"); __builtin_amdgcn_s_barrier(); asm volatile("" ::: "memory"); }
            }
    }
};

template <int FMT, int KDIV = 1, class Epi, class Sched>
__device__ __forceinline__ void gemm_phase(LAS unsigned char* lds, const void* Abase, const Sched& S, const Epi& E, int wave) {
    constexpr bool FP8 = FMT != 0;
    constexpr int KB = Sched::KB, NT = (FP8 ? K / 128 : K / 64) / KDIV;
    const int wid = wave, lane = lane_id(), tid = wid * 64 + lane, wr = wid >> 2, wc = wid & 3, fr = lane & 15, fq = lane >> 4;
    int Rr[2]; unsigned cofs[2], voffB[2];
#pragma unroll
    for (int i = 0; i < 2; ++i) { int R, C; stage_rc(tid * 16 + i * 8192, R, C); const int Rb = Epi::PERM ? ((R & ~31) + perm32(R & 31)) : R;
        Rr[i] = R; cofs[i] = (unsigned)C * 2u; voffB[i] = (unsigned)(Rb * KB + C * 2); }
    const size_t kstep = (size_t)(BK * 2);
    const size_t hstep = (size_t)HALF * KB;
    const unsigned ldsw = (unsigned)wid * 1024u;
    const int aoff = lds_byte(wr * 64 + fr, fq * 8), boff = lds_byte(wc * 32 + fr, fq * 8);
#define PG8_SA(b, h) (((b) * 2 + (h)) * HTB)
#define PG8_SB(b, h) ((4 + (b) * 2 + (h)) * HTB)
#define PG8_STAGE(bufoff, gbase, voff) do { _Pragma("unroll") for (int _i = 0; _i < 2; ++_i) \
        __builtin_amdgcn_global_load_lds((const unsigned*)((const char*)(gbase) + (voff)[_i]), (LAS unsigned*)(lds + (bufoff) + ldsw + _i * 8192), 16, 0, 0); } while (0)
#define PG8_STAGE2(bufoff, gbase, o0, o1) do { \
        __builtin_amdgcn_global_load_lds((const unsigned*)((const char*)(gbase) + (o0)), (LAS unsigned*)(lds + (bufoff) + ldsw), 16, 0, 0); \
        __builtin_amdgcn_global_load_lds((const unsigned*)((const char*)(gbase) + (o1)), (LAS unsigned*)(lds + (bufoff) + ldsw + 8192), 16, 0, 0); } while (0)
#define PG8_LDA(dst, b, h) do { _Pragma("unroll") for (int m = 0; m < 4; ++m) { \
        if constexpr (FP8) { dst##8[m].lo = *(const LAS i32x4*)(lds + PG8_SA(b, h) + aoff + m * 2048); dst##8[m].hi = *(const LAS i32x4*)(lds + PG8_SA(b, h) + aoff + m * 2048 + 1024); } \
        else { _Pragma("unroll") for (int k = 0; k < 2; ++k) dst[m][k] = *(const LAS bf16x8*)(lds + PG8_SA(b, h) + aoff + m * 2048 + k * 1024); } } } while (0)
#define PG8_LDB(dst, b, h) do { _Pragma("unroll") for (int n = 0; n < 2; ++n) { \
        if constexpr (FP8) { dst##8[n].lo = *(const LAS i32x4*)(lds + PG8_SB(b, h) + boff + n * 2048); dst##8[n].hi = *(const LAS i32x4*)(lds + PG8_SB(b, h) + boff + n * 2048 + 1024); } \
        else { _Pragma("unroll") for (int k = 0; k < 2; ++k) dst[n][k] = *(const LAS bf16x8*)(lds + PG8_SB(b, h) + boff + n * 2048 + k * 1024); } } } while (0)
#define PG8_MMA(ai, bj, At, Bt) do { __builtin_amdgcn_s_setprio(1); _Pragma("unroll") for (int m = 0; m < 4; ++m) _Pragma("unroll") for (int n = 0; n < 2; ++n) { \
        if constexpr (FMT == 2) { asm volatile("s_nop 1\n\tv_mfma_scale_f32_16x16x128_f8f6f4 %0, %1, %2, %0, %3, %4 op_sel_hi:[0,0,0] cbsz:2 blgp:2"     : "+v"(acc[ai][bj][m][n]) : "v"(__builtin_shufflevector(Bt##8[n], Bt##8[n], 0, 1, 2, 3, 4, 5)), "v"(__builtin_shufflevector(At##8[m], At##8[m], 0, 1, 2, 3, 4, 5)), "v"(Bt##8[n][6]), "v"(At##8[m][6])); } else \
        if constexpr (FP8) { asm volatile("v_mfma_scale_f32_16x16x128_f8f6f4 %0, %1, %2, %0, %3, %4 op_sel_hi:[0,0,0]" : "+v"(acc[ai][bj][m][n]) : "v"(Bt##8[n]), "v"(At##8[m]), "v"(sclW), "v"(sclA)); } \
        else { _Pragma("unroll") for (int k = 0; k < 2; ++k) acc[ai][bj][m][n] = __builtin_amdgcn_mfma_f32_16x16x32_bf16(Bt[n][k], At[m][k], acc[ai][bj][m][n], 0, 0, 0); } } \
        __builtin_amdgcn_s_setprio(0); } while (0)
#define PG8_WAIT_V(n) asm volatile("s_waitcnt vmcnt(" #n ")" ::: "memory")
#define PG8_WAIT_L(n) asm volatile("s_waitcnt lgkmcnt(" #n ")" ::: "memory")
#define PG8_BAR __builtin_amdgcn_s_barrier()
#define PG8_SCHED __builtin_amdgcn_sched_barrier(0)
    Unit cur, nxt; int ui = 0;
    if (!S.next(0, cur)) return;
    f32x4 acc[2][2][4][2];
#pragma unroll
    for (int a = 0; a < 2; ++a)
#pragma unroll
        for (int b = 0; b < 2; ++b)
#pragma unroll
            for (int m = 0; m < 4; ++m)
#pragma unroll
                for (int n = 0; n < 2; ++n) acc[a][b][m][n] = (f32x4){0.f, 0.f, 0.f, 0.f};
    bf16x8 At[4][2], B0[2][2], B1[2][2]; i32x8 At8[4], B08[2], B18[2];
    const int sclW = 0x77777777, sclA = 0x7f7f7f7f;
    unsigned vA00 = S.arow(cur, Rr[0]) + cofs[0], vA01 = S.arow(cur, Rr[1]) + cofs[1], vA10 = S.arow(cur, HALF + Rr[0]) + cofs[0], vA11 = S.arow(cur, HALF + Rr[1]) + cofs[1];
    bool has_next = S.next(1, nxt);
    unsigned nA00 = vA00, nA01 = vA01, nA10 = vA10, nA11 = vA11;
    if (has_next) { nA00 = S.arow(nxt, Rr[0]) + cofs[0]; nA01 = S.arow(nxt, Rr[1]) + cofs[1]; nA10 = S.arow(nxt, HALF + Rr[0]) + cofs[0]; nA11 = S.arow(nxt, HALF + Rr[1]) + cofs[1]; }
    asm volatile("" : "+v"(vA00), "+v"(vA01), "+v"(vA10), "+v"(vA11), "+v"(nA00), "+v"(nA01), "+v"(nA10), "+v"(nA11));
    const char* gA = (const char*)Abase;
    const char* cB = S.bptr(cur); const char* nB = has_next ? S.bptr(nxt) : cB;
    PG8_STAGE(PG8_SB(0, 0), cB, voffB); PG8_STAGE(PG8_SB(0, 1), cB + hstep, voffB); PG8_STAGE2(PG8_SA(0, 0), gA, vA00, vA01); PG8_STAGE2(PG8_SA(0, 1), gA, vA10, vA11);
    if (wr == 1) PG8_BAR;
    PG8_WAIT_V(2); PG8_BAR;
    PG8_STAGE(PG8_SB(1, 0), cB + kstep, voffB); PG8_STAGE2(PG8_SA(1, 0), gA + kstep, vA00, vA01); PG8_STAGE(PG8_SB(1, 1), cB + hstep + kstep, voffB);
    PG8_WAIT_V(6); PG8_BAR;
    for (;;) {
#pragma unroll 1
        for (int t = 0; t < NT; t += 2) {
            const bool last = (t == NT - 2);
            if constexpr (Epi::KSEG && !FP8) { if (t == 16 || t == 24) E.kseg(acc, cur, t, wr, fr); }
            const char* a1 = gA + (size_t)(t + 1) * kstep;
            const char* a2 = last ? gA : gA + (size_t)(t + 2) * kstep; const char* b2 = last ? nB : cB + (size_t)(t + 2) * kstep;
            const char* a3 = a2 + kstep; const char* b3 = b2 + kstep;
            const unsigned s00 = last ? nA00 : vA00, s01 = last ? nA01 : vA01, s10 = last ? nA10 : vA10, s11 = last ? nA11 : vA11;
            PG8_LDB(B0, 0, 0); PG8_LDB(B1, 0, 1); PG8_SCHED; PG8_LDA(At, 0, 0); PG8_STAGE2(PG8_SA(1, 1), a1, vA10, vA11);
            PG8_WAIT_V(8); PG8_WAIT_L(0); PG8_BAR; PG8_MMA(0, 0, At, B0); PG8_MMA(0, 1, At, B1); PG8_BAR; PG8_SCHED;
            PG8_LDA(At, 0, 1); PG8_STAGE(PG8_SB(0, 0), b2, voffB); PG8_STAGE(PG8_SB(0, 1), b2 + hstep, voffB); PG8_STAGE2(PG8_SA(0, 0), a2, s00, s01);
            PG8_WAIT_V(8); PG8_WAIT_L(0); PG8_BAR; PG8_MMA(1, 0, At, B0); PG8_MMA(1, 1, At, B1); PG8_BAR; PG8_SCHED;
            PG8_LDB(B0, 1, 0); PG8_LDB(B1, 1, 1); PG8_SCHED; PG8_LDA(At, 1, 0); PG8_STAGE2(PG8_SA(0, 1), a2, s10, s11);
            PG8_WAIT_V(8); PG8_WAIT_L(0); PG8_BAR; PG8_MMA(0, 0, At, B0); PG8_MMA(0, 1, At, B1); PG8_BAR; PG8_SCHED;
            PG8_LDA(At, 1, 1); PG8_STAGE(PG8_SB(1, 0), b3, voffB); PG8_STAGE(PG8_SB(1, 1), b3 + hstep, voffB); PG8_STAGE2(PG8_SA(1, 0), a3, s00, s01);
            PG8_WAIT_V(8); PG8_WAIT_L(0); PG8_BAR; PG8_MMA(1, 0, At, B0); PG8_MMA(1, 1, At, B1); PG8_BAR; PG8_SCHED;
        }
        Unit nn; const bool nn_has = has_next ? S.next(ui + 2, nn) : false;
        unsigned t00 = nA00, t01 = nA01, t10 = nA10, t11 = nA11;
        if (nn_has) { t00 = S.arow(nn, Rr[0]) + cofs[0]; t01 = S.arow(nn, Rr[1]) + cofs[1]; t10 = S.arow(nn, HALF + Rr[0]) + cofs[0]; t11 = S.arow(nn, HALF + Rr[1]) + cofs[1]; }
        asm volatile("" : "+v"(t00), "+v"(t01), "+v"(t10), "+v"(t11));
        if constexpr (FP8) { asm volatile("s_nop 15\n\ts_nop 15" ::: "memory"); PG8_SCHED; }
        if (wr == 0) PG8_BAR;
        E(acc, cur, wr, wc, fr, fq);
        if (!has_next) break;
#pragma unroll
        for (int a = 0; a < 2; ++a)
#pragma unroll
            for (int b = 0; b < 2; ++b)
#pragma unroll
                for (int m = 0; m < 4; ++m)
#pragma unroll
                    for (int n = 0; n < 2; ++n) acc[a][b][m][n] = (f32x4){0.f, 0.f, 0.f, 0.f};
        cur = nxt; cB = nB; vA00 = nA00; vA01 = nA01; vA10 = nA10; vA11 = nA11; ++ui;
        has_next = nn_has; nxt = nn; nA00 = t00; nA01 = t01; nA10 = t10; nA11 = t11;
        nB = has_next ? S.bptr(nxt) : cB;
        if (wr == 1) PG8_BAR;
    }
    PG8_WAIT_V(0);
    PG8_BAR;
#undef PG8_SA
#undef PG8_SB
#undef PG8_STAGE
#undef PG8_STAGE2
#undef PG8_LDA
#undef PG8_LDB
#undef PG8_MMA
#undef PG8_WAIT_V
#undef PG8_WAIT_L
#undef PG8_BAR
#undef PG8_SCHED
}
}

struct Frame {
    LAS unsigned char* lds;
    volatile LAS unsigned* LC;
    int tid, lane, wave, G, bx, rep;
    unsigned char* ws;
};
enum { I_X = 0, I_MEM, I_LNMIX, I_WIN, I_CONVW, I_CONVB, I_WRGA, I_BRGA, I_WRGI, I_BRGI, I_LAM, I_GMVG, I_WSP, I_BSP, I_MEMG, I_WMK, I_WMV,
       I_OUTG, I_WOUT, I_LNFFN, I_WR, I_BR, I_WGU, I_BGU, I_WD, I_BD, I_FING };

__device__ __forceinline__ const float* inp(const Frame& F, int i) {
    const LAS unsigned* p = (const LAS unsigned*)(F.lds + LDSCTL_OFF) + LC_PTR + 2 * i;
    const unsigned lo = __builtin_amdgcn_readfirstlane(p[0]), hi = __builtin_amdgcn_readfirstlane(p[1]);
    return (const float*)(((unsigned long long)hi << 32) | lo);
}
__device__ __forceinline__ void p0_tr_item(const float* W, int N, bf16* WT, int Kd, const float* kscale, LAS float* scr, int kb, int nb, int lane) {
    const int k0 = kb * 64, n0 = nb * 64, lr = lane >> 4, lc = lane & 15;
    f32x4 v[16];
#pragma unroll
    for (int i = 0; i < 16; ++i) v[i] = *(const GAS f32x4*)(W + (size_t)(k0 + 4 * i + lr) * N + n0 + 4 * lc);
    if (kscale) {
#pragma unroll
        for (int i = 0; i < 16; ++i) { const float s = kscale[k0 + 4 * i + lr]; v[i] = v[i] * s; } }
#pragma unroll
    for (int i = 0; i < 16; ++i) { LAS float* d = scr + (4 * i + lr) * 65 + 4 * lc; d[0] = v[i][0]; d[1] = v[i][1]; d[2] = v[i][2]; d[3] = v[i][3]; }
    LDS_WAIT();
    const int c = lane & 7;
#pragma unroll
    for (int j = 0; j < 8; ++j) { const int n = (lane >> 3) + 8 * j; const LAS float* s = scr + (8 * c) * 65 + n;
        v4u o; o.x = pk2(s[0 * 65], s[1 * 65]); o.y = pk2(s[2 * 65], s[3 * 65]); o.z = pk2(s[4 * 65], s[5 * 65]); o.w = pk2(s[6 * 65], s[7 * 65]);
        *(GAS v4u*)(WT + (size_t)(n0 + n) * Kd + k0 + 8 * c) = o; }
    LDS_WAIT();
}
struct TrItem { const float* W; unsigned char* WT; const float* ks; int N, kb, nb, f6; };
__device__ __forceinline__ TrItem p0_decode_fp8(const float* wgu, const float* wd, unsigned char* WguT, unsigned char* WdT, const float* g, int r) {
    TrItem t;
    if (r < 65536) { const int e = r >> 11, q = r & 2047; t.W = wgu + (size_t)e * 2048 * 4096; t.WT = WguT + (size_t)e * 4096 * 2048; t.ks = g; t.N = 4096; t.kb = q >> 7; t.nb = q & 127; t.f6 = 1; }
    else { r -= 65536; const int e = r >> 10, q = r & 1023; t.W = wd + (size_t)e * 2048 * 2048; t.WT = WdT + (size_t)e * 2048 * 2048; t.ks = nullptr; t.N = 2048; t.kb = q >> 6; t.nb = q & 63; t.f6 = 0; }
    return t;
}
__device__ __forceinline__ void p0_tr_load(const TrItem& t, f32x4 (&v)[16], int lane) {
    const int k0 = t.kb * 128, n0 = t.nb * 32, lr = lane >> 3, lc = lane & 7;
#pragma unroll
    for (int i = 0; i < 16; ++i) v[i] = __builtin_nontemporal_load((const GAS f32x4*)(t.W + (size_t)(k0 + 16 * lr + i) * t.N + n0 + 4 * lc));
}
__device__ __forceinline__ void p0_tr_finish_fp6(const TrItem& t, const f32x4 (&v)[16], LAS float* scr, int lane) {
    const int k0 = t.kb * 128, n0 = t.nb * 32, lr = lane >> 3, lc = lane & 7;
#pragma unroll
    for (int i = 0; i < 16; ++i) { const float sc = t.ks ? t.ks[k0 + 16 * lr + i] : 1.0f; LAS float* d = scr + (16 * lr + i) * 33 + 4 * lc; d[0] = v[i][0] * sc; d[1] = v[i][1] * sc; d[2] = v[i][2] * sc; d[3] = v[i][3] * sc; }
    LDS_WAIT();
    const int n = lane & 31, hf = lane >> 5;
    v4u lo[2], hi[2];
#pragma unroll
    for (int bb = 0; bb < 2; ++bb) { float x[32];
#pragma unroll
        for (int e = 0; e < 32; ++e) x[e] = scr[(32 * (2 * hf + bb) + e) * 33 + n];
        pack_fp6(x, lo[bb], hi[bb]); }
    LDS_WAIT();
    LAS unsigned char* ob = (LAS unsigned char*)scr;
#pragma unroll
    for (int bb = 0; bb < 2; ++bb) { *(LAS v4u*)(ob + n * 128 + 16 * (2 * hf + bb)) = lo[bb]; *(LAS v4u*)(ob + n * 128 + 64 + 16 * (2 * hf + bb)) = hi[bb]; }
    LDS_WAIT();
#pragma unroll
    for (int p = 0; p < 4; ++p) { const int idx = p * 64 + lane, row = idx >> 3, ch = idx & 7;
        __builtin_nontemporal_store(*(const LAS v4u*)(ob + row * 128 + 16 * ch), (GAS v4u*)(t.WT + (size_t)(n0 + row) * 2048 + k0 + 16 * ch)); }
    LDS_WAIT();
}
__device__ __forceinline__ void p0_tr_finish_fp8(const TrItem& t, const f32x4 (&v)[16], LAS float* scr, int lane) {
    const int k0 = t.kb * 128, n0 = t.nb * 32, lr = lane >> 3, lc = lane & 7;
#pragma unroll
    for (int i = 0; i < 16; ++i) { LAS float* d = scr + (16 * lr + i) * 33 + 4 * lc; d[0] = v[i][0] * 256.f; d[1] = v[i][1] * 256.f; d[2] = v[i][2] * 256.f; d[3] = v[i][3] * 256.f; }
    LDS_WAIT();
    const int n = lane & 31, hf = lane >> 5;
    v4u o[2][2];
#pragma unroll
    for (int bb = 0; bb < 2; ++bb) { float x[32];
#pragma unroll
        for (int e = 0; e < 32; ++e) x[e] = scr[(32 * (2 * hf + bb) + e) * 33 + n];
#pragma unroll
        for (int q = 0; q < 2; ++q) { o[bb][q].x = pk4_fp8_sc(x[16 * q], x[16 * q + 1], x[16 * q + 2], x[16 * q + 3]); o[bb][q].y = pk4_fp8_sc(x[16 * q + 4], x[16 * q + 5], x[16 * q + 6], x[16 * q + 7]);
            o[bb][q].z = pk4_fp8_sc(x[16 * q + 8], x[16 * q + 9], x[16 * q + 10], x[16 * q + 11]); o[bb][q].w = pk4_fp8_sc(x[16 * q + 12], x[16 * q + 13], x[16 * q + 14], x[16 * q + 15]); } }
    LDS_WAIT();
    LAS unsigned char* ob = (LAS unsigned char*)scr;
#pragma unroll
    for (int bb = 0; bb < 2; ++bb) { *(LAS v4u*)(ob + n * 128 + 32 * (2 * hf + bb)) = o[bb][0]; *(LAS v4u*)(ob + n * 128 + 32 * (2 * hf + bb) + 16) = o[bb][1]; }
    LDS_WAIT();
#pragma unroll
    for (int p = 0; p < 4; ++p) { const int idx = p * 64 + lane, row = idx >> 3, ch = idx & 7;
        __builtin_nontemporal_store(*(const LAS v4u*)(ob + row * 128 + 16 * ch), (GAS v4u*)(t.WT + (size_t)(n0 + row) * 2048 + k0 + 16 * ch)); }
    LDS_WAIT();
}
__device__ __forceinline__ void norm_row_bf16(const float* xrow, const float* g, bf16* orow, int lane) {
    const GAS f32x4* xr = (const GAS f32x4*)xrow + lane;
    f32x4 v[8]; float s = 0.f;
#pragma unroll
    for (int j = 0; j < 8; ++j) { v[j] = __builtin_nontemporal_load(xr + 64 * j); s += (v[j][0] * v[j][0] + v[j][1] * v[j][1]) + (v[j][2] * v[j][2] + v[j][3] * v[j][3]); }
    const float r = 1.0f / __builtin_sqrtf(wave_sum(s) * (1.0f / D) + EPS);
    GAS v2u* o8 = (GAS v2u*)orow + lane;
#pragma unroll
    for (int j = 0; j < 8; ++j) { const f32x4 gg = ((const GAS f32x4*)g)[lane + 64 * j];
        v2u o; o.x = pk2(v[j][0] * r * gg[0], v[j][1] * r * gg[1]); o.y = pk2(v[j][2] * r * gg[2], v[j][3] * r * gg[3]); o8[64 * j] = o; }
}
__device__ __forceinline__ void raw_row_bf16(const float* xrow, bf16* orow, float* rstd_out, int lane) {
    const GAS f32x4* xr = (const GAS f32x4*)xrow + lane;
    f32x4 v[8]; float s = 0.f;
#pragma unroll
    for (int j = 0; j < 8; ++j) { v[j] = __builtin_nontemporal_load(xr + 64 * j); s += (v[j][0] * v[j][0] + v[j][1] * v[j][1]) + (v[j][2] * v[j][2] + v[j][3] * v[j][3]); }
    GAS v2u* o8 = (GAS v2u*)orow + lane;
#pragma unroll
    for (int j = 0; j < 8; ++j) { v2u o; o.x = pk2(v[j][0], v[j][1]); o.y = pk2(v[j][2], v[j][3]); o8[64 * j] = o; }
    const float r = 1.0f / __builtin_sqrtf(wave_sum(s) * (1.0f / D) + EPS);
    if (lane == 0) *rstd_out = r;
}
__device__ __forceinline__ void p0_prologue(Frame& F) {
    LAS float* scr = (LAS float*)(F.lds + F.wave * 16896);
    const int gw = F.bx * 8 + F.wave, NGW = F.G * 8;
    bf16* WinT = (bf16*)(F.ws + WS_WIN); bf16* WoutT = (bf16*)(F.ws + WS_WOUT); bf16* WkT = (bf16*)(F.ws + WS_WKT); bf16* WvT = (bf16*)(F.ws + WS_WVT);
    bf16* WaT = (bf16*)(F.ws + WS_WA); bf16* WiT = (bf16*)(F.ws + WS_WI); unsigned char* WguT = F.ws + WS_WGU; unsigned char* WdT = F.ws + WS_WD;
    constexpr int I_IN = 32 * 56, I_OUT = 32 * 32, I_KV = 32 * 8, I_RG = 2 * 2 * 8, I_GU = 32 * 32 * 64, I_DN = 32 * 32 * 32;
    constexpr int NITEMS = I_IN + I_OUT + 2 * I_KV + 2 * I_RG;
    { const float* wgu = inp(F, I_WGU); const float* wd = inp(F, I_WD); const float* gf = inp(F, I_LNFFN);
      constexpr int NF = I_GU + I_DN;
      f32x4 va[16], vb[16]; TrItem ta, tb;
      int it = gw;
      if (it < NF) { ta = p0_decode_fp8(wgu, wd, WguT, WdT, gf, it); p0_tr_load(ta, va, F.lane); }
      for (; it < NF; it += 2 * NGW) {
          const bool hb = it + NGW < NF, ha = it + 2 * NGW < NF;
          if (hb) { tb = p0_decode_fp8(wgu, wd, WguT, WdT, gf, it + NGW); p0_tr_load(tb, vb, F.lane); }
          if (ta.f6) p0_tr_finish_fp6(ta, va, scr, F.lane); else p0_tr_finish_fp8(ta, va, scr, F.lane);
          if (ha) { ta = p0_decode_fp8(wgu, wd, WguT, WdT, gf, it + 2 * NGW); p0_tr_load(ta, va, F.lane); }
          if (hb) { if (tb.f6) p0_tr_finish_fp6(tb, vb, scr, F.lane); else p0_tr_finish_fp8(tb, vb, scr, F.lane); }
      } }
    for (int it = gw; it < NITEMS; it += NGW) {
        int r = it;
        if (r < I_IN) { p0_tr_item(inp(F, I_WIN), INC, WinT, 2048, inp(F, I_LNMIX), scr, r / 56, r % 56, F.lane); continue; } r -= I_IN;
        if (r < I_OUT) { p0_tr_item(inp(F, I_WOUT), 2048, WoutT, 2048, inp(F, I_OUTG), scr, r >> 5, r & 31, F.lane); continue; } r -= I_OUT;
        if (r < I_KV) { p0_tr_item(inp(F, I_WMK), 512, WkT, 2048, nullptr, scr, r >> 3, r & 7, F.lane); continue; } r -= I_KV;
        if (r < I_KV) { p0_tr_item(inp(F, I_WMV), 512, WvT, 2048, nullptr, scr, r >> 3, r & 7, F.lane); continue; } r -= I_KV;
        if (r < I_RG) { const int h = r >> 2, q = r & 3; p0_tr_item(inp(F, I_WRGA) + h * 16384, 128, WaT + h * 16384, 128, nullptr, scr, q >> 1, q & 1, F.lane); continue; } r -= I_RG;
        { const int h = r >> 2, q = r & 3; p0_tr_item(inp(F, I_WRGI) + h * 16384, 128, WiT + h * 16384, 128, nullptr, scr, q >> 1, q & 1, F.lane); }
    }
    bf16* XB = (bf16*)(F.ws + WS_XB); bf16* MEMN = (bf16*)(F.ws + WS_MEMN);
    for (int m = gw; m < NTOK; m += NGW) raw_row_bf16(inp(F, I_X) + (size_t)m * D, XB + (size_t)m * D, (float*)(F.ws + WS_RSTD0) + m, F.lane);
    for (int m = gw; m < NB * MEM; m += NGW) norm_row_bf16(inp(F, I_MEM) + (size_t)m * D, inp(F, I_MEMG), MEMN + (size_t)m * D, F.lane);
    { v4u* gz = (v4u*)(F.ws + WS_GRAN); for (int i = F.bx * 512 + F.tid; i < (int)(4 * MiB / 16); i += F.G * 512) gz[i] = (v4u){0u, 0u, 0u, 0u}; }
    const int gt = F.bx * 512 + F.tid, NGT = F.G * 512;
    bf16* WSP = (bf16*)(F.ws + WS_WSP); float* WRP = (float*)(F.ws + WS_WRP);
    for (int i = gt; i < 4 * 128 * 128; i += NGT) { const int s = i & 127, t = (i >> 7) & 127; WSP[i] = (bf16)f2bf(s <= t ? inp(F, I_WSP)[i] : 0.f); }
    for (int i = gt; i < 2048 * 32; i += NGT) { const int k = i >> 5, e = i & 31; WRP[((k >> 2) * 32 + e) * 4 + (k & 3)] = inp(F, I_LNFFN)[k] * inp(F, I_WR)[i]; }
}

__device__ __forceinline__ void xattn_unit(Frame& F, int b, int h, int part) {
    constexpr int KST = 272, VST = 528, VOFF = 256 * KST;
    const bf16* KB = (const bf16*)(F.ws + WS_KB); const bf16* VT = (const bf16*)(F.ws + WS_VT);
    const bf16* P = (const bf16*)(F.ws + WS_P); bf16* YB = (bf16*)(F.ws + WS_YBUF); unsigned long long* ssx = (unsigned long long*)(F.ws + (F.rep ? WS_DUMMY : CTL_SS)) + 2 * NTOK;
#pragma unroll
    for (int p = 0; p < 8; ++p) { const int idx = F.tid + 512 * p, row = idx >> 4, c16 = idx & 15;
        const v4u kv = *(const GAS v4u*)(KB + (size_t)(b * MEM + row) * 512 + h * HD + c16 * 8); *(LAS v4u*)(F.lds + row * KST + c16 * 16) = kv; }
#pragma unroll
    for (int p = 0; p < 8; ++p) { const int idx = F.tid + 512 * p, row = idx >> 5, c16 = idx & 31;
        const v4u vv = *(const GAS v4u*)(VT + (size_t)(h * HD + row) * 2048 + b * MEM + c16 * 8); *(LAS v4u*)(F.lds + VOFF + row * VST + c16 * 16) = vv; }
    const int q = F.lane & 15, quad = F.lane >> 4;
    bf16x8 qn[4];
    { const int tok = b * T + part * 512 + F.wave * 16 + q;
#pragma unroll
      for (int s = 0; s < 4; ++s) qn[s] = *(const GAS bf16x8*)(P + (size_t)tok * INC + 3072 + h * HD + s * 32 + quad * 8); }
    __syncthreads();
#pragma unroll 1
    for (int round = 0; round < 4; ++round) {
        const int tok = b * T + part * 512 + round * 128 + F.wave * 16 + q;
        bf16x8 qf[4];
#pragma unroll
        for (int s = 0; s < 4; ++s) qf[s] = qn[s];
        if (round < 3) { const int tn = tok + 128;
#pragma unroll
            for (int s = 0; s < 4; ++s) qn[s] = *(const GAS bf16x8*)(P + (size_t)tn * INC + 3072 + h * HD + s * 32 + quad * 8); }
        f32x4 sacc[16];
#pragma unroll
        for (int kb = 0; kb < 16; ++kb) { sacc[kb] = (f32x4){0.f, 0.f, 0.f, 0.f};
#pragma unroll
            for (int s = 0; s < 4; ++s) { const bf16x8 kf = *(const LAS bf16x8*)(F.lds + (kb * 16 + q) * KST + (s * 32 + quad * 8) * 2);
                sacc[kb] = __builtin_amdgcn_mfma_f32_16x16x32_bf16(kf, qf[s], sacc[kb], 0, 0, 0); }
            if (kb & 1) __builtin_amdgcn_sched_barrier(0); }
        float mx = -3.0e38f;
#pragma unroll
        for (int kb = 0; kb < 16; ++kb) mx = fmaxf(fmaxf(fmaxf(sacc[kb][0], sacc[kb][1]), fmaxf(sacc[kb][2], sacc[kb][3])), mx);
        mx = fmaxf(mx, __shfl_xor(mx, 16)); mx = fmaxf(mx, __shfl_xor(mx, 32));
        float sum = 0.f;
#pragma unroll
        for (int kb = 0; kb < 16; ++kb)
#pragma unroll
            for (int j = 0; j < 4; ++j) { const float pv = fast_exp2(sacc[kb][j] - mx); sacc[kb][j] = pv; sum += pv; }
        sum += __shfl_xor(sum, 16); sum += __shfl_xor(sum, 32);
        const float rs = 1.0f / sum;
        bf16x8 pf[8];
#pragma unroll
        for (int s2 = 0; s2 < 8; ++s2) { v4u w; w.x = pk2(sacc[2 * s2][0], sacc[2 * s2][1]); w.y = pk2(sacc[2 * s2][2], sacc[2 * s2][3]);
            w.z = pk2(sacc[2 * s2 + 1][0], sacc[2 * s2 + 1][1]); w.w = pk2(sacc[2 * s2 + 1][2], sacc[2 * s2 + 1][3]); pf[s2] = __builtin_bit_cast(bf16x8, w); }
        float ssq = 0.f;
#pragma unroll
        for (int db = 0; db < 8; ++db) { f32x4 o = (f32x4){0.f, 0.f, 0.f, 0.f};
#pragma unroll
            for (int s2 = 0; s2 < 8; ++s2) { const LAS unsigned char* vp = F.lds + VOFF + (db * 16 + q) * VST + (s2 * 32 + quad * 4) * 2;
                const v2u lo = *(const LAS v2u*)vp, hi = *(const LAS v2u*)(vp + 32);
                v4u w; w.x = lo.x; w.y = lo.y; w.z = hi.x; w.w = hi.y;
                o = __builtin_amdgcn_mfma_f32_16x16x32_bf16(__builtin_bit_cast(bf16x8, w), pf[s2], o, 0, 0, 0); }
            o = o * rs; ssq += (o[0] * o[0] + o[1] * o[1]) + (o[2] * o[2] + o[3] * o[3]);
            v2u w; w.x = pk2(o[0], o[1]); w.y = pk2(o[2], o[3]);
            *(GAS v2u*)(YB + (size_t)tok * D + 1536 + h * HD + db * 16 + quad * 4) = w;
            __builtin_amdgcn_sched_barrier(0); }
        ssq += __shfl_xor(ssq, 16); ssq += __shfl_xor(ssq, 32);
        if (quad == 0) atomicAdd(ssx + tok, (unsigned long long)(ssq * SS_SCALE + 0.5f));
    }
    __syncthreads();
}

__device__ __forceinline__ void gmlp_unit(Frame& F, int b, int c) {
    constexpr int VST = 272, GST = 128 * VST;
    const bf16* P = (const bf16*)(F.ws + WS_P); bf16* YB = (bf16*)(F.ws + WS_YBUF); unsigned long long* ssg = (unsigned long long*)(F.ws + (F.rep ? WS_DUMMY : CTL_SS)) + NTOK;
    const bf16* WSP = (const bf16*)(F.ws + WS_WSP);
    const int tok0 = b * T + c * 128, w = F.wave, lane = F.lane;
    const int q = lane & 15, quad = lane >> 4, t = w * 16 + q, tok = tok0 + t;
    float gv[8];
    { const float* gp = inp(F, I_GMVG) + 8 * lane;
#pragma unroll
      for (int e = 0; e < 8; ++e) gv[e] = gp[e]; }
#pragma unroll
    for (int half = 0; half < 2; ++half) {
        v4u raw[8];
#pragma unroll
        for (int i = 0; i < 8; ++i) raw[i] = *(const GAS v4u*)(P + (size_t)(tok0 + w * 16 + half * 8 + i) * INC + 2560 + 8 * lane);
#pragma unroll
        for (int i = 0; i < 8; ++i) { const int s = w * 16 + half * 8 + i;
            float f[8] = {bflo(raw[i].x), bfhi(raw[i].x), bflo(raw[i].y), bfhi(raw[i].y), bflo(raw[i].z), bfhi(raw[i].z), bflo(raw[i].w), bfhi(raw[i].w)};
            float ssq = 0.f;
#pragma unroll
            for (int e = 0; e < 8; ++e) ssq += f[e] * f[e];
            const float r = 1.0f / __builtin_sqrtf(wave_sum(ssq) * (1.0f / GMW) + EPS);
            LAS unsigned char* dst = F.lds + (lane >> 4) * GST + ((lane & 15) * 8) * VST + s * 2;
#pragma unroll
            for (int e = 0; e < 8; ++e) *(LAS bf16*)(dst + e * VST) = (bf16)f2bf(f[e] * r * gv[e]); }
    }
    __syncthreads();
    float ssq = 0.f;
#pragma unroll 1
    for (int g = 0; g < 4; ++g) {
        bf16x8 wf[4];
#pragma unroll
        for (int ks = 0; ks < 4; ++ks) wf[ks] = *(const GAS bf16x8*)(WSP + ((size_t)g * 128 + t) * 128 + ks * 32 + quad * 8);
        const float bs = inp(F, I_BSP)[g * 128 + t];
        v2u guv[8];
#pragma unroll
        for (int db = 0; db < 8; ++db) guv[db] = *(const GAS v2u*)(P + (size_t)tok * INC + 2048 + g * HD + db * 16 + quad * 4);
#pragma unroll
        for (int db = 0; db < 8; ++db) { f32x4 a = (f32x4){0.f, 0.f, 0.f, 0.f};
#pragma unroll
            for (int ks = 0; ks < 4; ++ks) { const bf16x8 vf = *(const LAS bf16x8*)(F.lds + g * GST + (db * 16 + q) * VST + (ks * 32 + quad * 8) * 2);
                a = __builtin_amdgcn_mfma_f32_16x16x32_bf16(vf, wf[ks], a, 0, 0, 0); }
            const v2u gu = guv[db];
            const float y0 = bflo(gu.x) * (a[0] + bs), y1 = bfhi(gu.x) * (a[1] + bs), y2 = bflo(gu.y) * (a[2] + bs), y3 = bfhi(gu.y) * (a[3] + bs);
            ssq += (y0 * y0 + y1 * y1) + (y2 * y2 + y3 * y3);
            v2u o; o.x = pk2(y0, y1); o.y = pk2(y2, y3);
            *(GAS v2u*)(YB + (size_t)tok * D + 1024 + g * HD + db * 16 + quad * 4) = o; }
    }
    ssq += __shfl_xor(ssq, 16); ssq += __shfl_xor(ssq, 32);
    if (quad == 0) atomicAdd(ssg + tok, (unsigned long long)(ssq * SS_SCALE + 0.5f));
    __syncthreads();
}

template <bool FINAL> __device__ __forceinline__ void rg_unit(Frame& F, int b, int c, int h) {
    constexpr int XST = 272, GOFF = 128 * XST, YOFF = 2 * 128 * XST;
    const bf16* P = (const bf16*)(F.ws + WS_P); bf16* YB = (bf16*)(F.ws + WS_YBUF); unsigned long long* ssr = (unsigned long long*)(F.ws + (F.rep ? WS_DUMMY : CTL_SS));
    const bf16* WaT = (const bf16*)(F.ws + WS_WA) + h * 16384; const bf16* WiT = (const bf16*)(F.ws + WS_WI) + h * 16384;
    float* Aend = (float*)(F.ws + WS_CARRY); float* Hend = Aend + NB * NCHUNK * RGW;
    const int tok0 = b * T + c * 128, w = F.wave, lane = F.lane, tid = F.tid;
    { const int cg = tid & 15, tq = tid >> 4, ch0 = h * HD + cg * 8;
      float cw[4][8], cb[8];
#pragma unroll
      for (int j = 0; j < 4; ++j) { const f32x4 a0 = *(const GAS f32x4*)(inp(F, I_CONVW) + j * RGW + ch0), a1 = *(const GAS f32x4*)(inp(F, I_CONVW) + j * RGW + ch0 + 4);
          cw[j][0] = a0[0]; cw[j][1] = a0[1]; cw[j][2] = a0[2]; cw[j][3] = a0[3]; cw[j][4] = a1[0]; cw[j][5] = a1[1]; cw[j][6] = a1[2]; cw[j][7] = a1[3]; }
      { const f32x4 a0 = *(const GAS f32x4*)(inp(F, I_CONVB) + ch0), a1 = *(const GAS f32x4*)(inp(F, I_CONVB) + ch0 + 4);
          cb[0] = a0[0]; cb[1] = a0[1]; cb[2] = a0[2]; cb[3] = a0[3]; cb[4] = a1[0]; cb[5] = a1[1]; cb[6] = a1[2]; cb[7] = a1[3]; }
      v4u raw[7];
#pragma unroll
      for (int r = 0; r < 7; ++r) { const int trow = c * 128 + tq * 4 - 3 + r;
          raw[r] = (trow >= 0) ? *(const GAS v4u*)(P + (size_t)(b * T + trow) * INC + ch0) : (v4u){0u, 0u, 0u, 0u}; }
#pragma unroll
      for (int tt = 0; tt < 4; ++tt) { float o[8];
#pragma unroll
          for (int e = 0; e < 8; ++e) o[e] = cb[e];
#pragma unroll
          for (int j = 0; j < 4; ++j) { const v4u rw = raw[tt + j];
              const float f[8] = {bflo(rw.x), bfhi(rw.x), bflo(rw.y), bfhi(rw.y), bflo(rw.z), bfhi(rw.z), bflo(rw.w), bfhi(rw.w)};
#pragma unroll
              for (int e = 0; e < 8; ++e) o[e] += cw[j][e] * f[e]; }
          v4u wv; wv.x = pk2(o[0], o[1]); wv.y = pk2(o[2], o[3]); wv.z = pk2(o[4], o[5]); wv.w = pk2(o[6], o[7]);
          *(LAS v4u*)(F.lds + (tq * 4 + tt) * XST + cg * 16) = wv; }
      if (FINAL) {
#pragma unroll
          for (int p = 0; p < 4; ++p) { const int idx = tid + 512 * p, row = idx >> 4, c16 = idx & 15;
              const v4u gvv = *(const GAS v4u*)(P + (size_t)(tok0 + row) * INC + RGW + h * HD + c16 * 8); *(LAS v4u*)(F.lds + GOFF + row * XST + c16 * 16) = gvv; } }
    }
    __syncthreads();
    const int q = lane & 15, quad = lane >> 4, ch = w * 16 + q, gc = h * HD + ch;
    bf16x8 waf[4], wif[4];
#pragma unroll
    for (int ks = 0; ks < 4; ++ks) { waf[ks] = *(const GAS bf16x8*)(WaT + (size_t)ch * 128 + ks * 32 + quad * 8); wif[ks] = *(const GAS bf16x8*)(WiT + (size_t)ch * 128 + ks * 32 + quad * 8); }
    f32x4 ar[8], ai[8];
#pragma unroll
    for (int tb = 0; tb < 8; ++tb) { ar[tb] = (f32x4){0.f, 0.f, 0.f, 0.f}; ai[tb] = (f32x4){0.f, 0.f, 0.f, 0.f};
#pragma unroll
        for (int ks = 0; ks < 4; ++ks) { const bf16x8 xf = *(const LAS bf16x8*)(F.lds + (tb * 16 + q) * XST + (ks * 32 + quad * 8) * 2);
            ar[tb] = __builtin_amdgcn_mfma_f32_16x16x32_bf16(xf, waf[ks], ar[tb], 0, 0, 0);
            ai[tb] = __builtin_amdgcn_mfma_f32_16x16x32_bf16(xf, wif[ks], ai[tb], 0, 0, 0); } }
    const float ba = inp(F, I_BRGA)[gc], bi = inp(F, I_BRGI)[gc];
    const float lam = inp(F, I_LAM)[gc];
    const float sp8 = 8.0f * log1pf(__expf(-lam));
#pragma unroll
    for (int tb = 0; tb < 8; ++tb)
#pragma unroll
        for (int tt = 0; tt < 4; ++tt) { const int t = tb * 16 + quad * 4 + tt;
            const float r = sigmoidf_(ar[tb][tt] + ba), ig = sigmoidf_(ai[tb][tt] + bi);
            const float la = -sp8 * r, a = __expf(la), t2 = 2.0f * la;
            const float om = (t2 > -0.05f) ? -t2 * (1.0f + t2 * (0.5f + t2 * (0.16666667f + t2 * 0.041666668f))) : 1.0f - __expf(t2);
            const float xcv = bf2f(*(const LAS bf16*)(F.lds + t * XST + ch * 2));
            ar[tb][tt] = a; ai[tb][tt] = __builtin_amdgcn_sqrtf(om) * ig * xcv; }
    float carry = 0.f, PC = 1.f;
    if (FINAL) {
#pragma unroll
        for (int base = 0; base < NCHUNK; base += 8) {
            if (base < c) { float cA[8], cH[8];
#pragma unroll
                for (int j = 0; j < 8; ++j) { const int cs = (base + j < c) ? base + j : c - 1; cA[j] = Aend[(b * NCHUNK + cs) * RGW + gc]; cH[j] = Hend[(b * NCHUNK + cs) * RGW + gc]; }
#pragma unroll
                for (int j = 0; j < 8; ++j) if (base + j < c) carry = cH[j] + cA[j] * carry; } } }
#pragma unroll
    for (int tb = 0; tb < 8; ++tb) {
        const float a0 = ar[tb][0], a1 = ar[tb][1], a2 = ar[tb][2], a3 = ar[tb][3], u0 = ai[tb][0], u1 = ai[tb][1], u2 = ai[tb][2], u3 = ai[tb][3];
        float Pl = a0 * a1 * a2 * a3, Hl = ((u0 * a1 + u1) * a2 + u2) * a3 + u3;
        { const float Pp = __shfl_up(Pl, 16), Hp = __shfl_up(Hl, 16); if (quad >= 1) { Hl = Hp * Pl + Hl; Pl = Pp * Pl; } }
        { const float Pp = __shfl_up(Pl, 32), Hp = __shfl_up(Hl, 32); if (quad >= 2) { Hl = Hp * Pl + Hl; Pl = Pp * Pl; } }
        float Pe = __shfl_up(Pl, 16), He = __shfl_up(Hl, 16); if (quad == 0) { Pe = 1.f; He = 0.f; }
        const float PB = __shfl(Pl, 48 + q), HB = __shfl(Hl, 48 + q);
        if (FINAL) {
            float hp = He + Pe * carry;
            const float g0 = bf2f(*(const LAS bf16*)(F.lds + GOFF + (tb * 16 + quad * 4 + 0) * XST + ch * 2)), g1 = bf2f(*(const LAS bf16*)(F.lds + GOFF + (tb * 16 + quad * 4 + 1) * XST + ch * 2));
            const float g2 = bf2f(*(const LAS bf16*)(F.lds + GOFF + (tb * 16 + quad * 4 + 2) * XST + ch * 2)), g3 = bf2f(*(const LAS bf16*)(F.lds + GOFF + (tb * 16 + quad * 4 + 3) * XST + ch * 2));
            hp = a0 * hp + u0; *(LAS bf16*)(F.lds + YOFF + (tb * 16 + quad * 4 + 0) * XST + ch * 2) = (bf16)f2bf(g0 * hp);
            hp = a1 * hp + u1; *(LAS bf16*)(F.lds + YOFF + (tb * 16 + quad * 4 + 1) * XST + ch * 2) = (bf16)f2bf(g1 * hp);
            hp = a2 * hp + u2; *(LAS bf16*)(F.lds + YOFF + (tb * 16 + quad * 4 + 2) * XST + ch * 2) = (bf16)f2bf(g2 * hp);
            hp = a3 * hp + u3; *(LAS bf16*)(F.lds + YOFF + (tb * 16 + quad * 4 + 3) * XST + ch * 2) = (bf16)f2bf(g3 * hp);
            carry = HB + PB * carry;
        } else { carry = HB + PB * carry; PC = PC * PB; }
    }
    if (!FINAL) { if (quad == 0) { Aend[(b * NCHUNK + c) * RGW + gc] = PC; Hend[(b * NCHUNK + c) * RGW + gc] = carry; } }
    else {
        __syncthreads();
        float ssq = 0.f; const int row = tid >> 2, q4 = tid & 3;
#pragma unroll
        for (int p = 0; p < 4; ++p) { const int c16 = p * 4 + q4;     const v4u yv = *(const LAS v4u*)(F.lds + YOFF + row * XST + c16 * 16);
            *(GAS v4u*)(YB + (size_t)(tok0 + row) * D + h * HD + c16 * 8) = yv;
            const float f[8] = {bflo(yv.x), bfhi(yv.x), bflo(yv.y), bfhi(yv.y), bflo(yv.z), bfhi(yv.z), bflo(yv.w), bfhi(yv.w)};
#pragma unroll
            for (int e = 0; e < 8; ++e) ssq += f[e] * f[e]; }
        ssq += __shfl_xor(ssq, 1); ssq += __shfl_xor(ssq, 2);
        if (q4 == 0) atomicAdd(ssr + tok0 + row, (unsigned long long)(ssq * SS_SCALE + 0.5f));
    }
    __syncthreads();
}

__device__ __forceinline__ void rg_unit_lb(Frame& F, int b, int c, int h) {
    constexpr bool FINAL = true;
    constexpr int XST = 272, GOFF = 128 * XST, YOFF = 2 * 128 * XST;
    const bf16* P = (const bf16*)(F.ws + WS_P); bf16* YB = (bf16*)(F.ws + WS_YBUF); unsigned long long* ssr = (unsigned long long*)(F.ws + (F.rep ? WS_DUMMY : CTL_SS));
    const bf16* WaT = (const bf16*)(F.ws + WS_WA) + h * 16384; const bf16* WiT = (const bf16*)(F.ws + WS_WI) + h * 16384;
    typedef GAS unsigned long long gu64;
    gu64* GA = (gu64*)(F.ws + WS_GRAN); gu64* GH = GA + NB * NCHUNK * RGW;
    const int tok0 = b * T + c * 128, w = F.wave, lane = F.lane, tid = F.tid;
    const int q = lane & 15, quad = lane >> 4, ch = w * 16 + q, gc = h * HD + ch;
    bf16x8 waf[4], wif[4];
#pragma unroll
    for (int ks = 0; ks < 4; ++ks) { waf[ks] = *(const GAS bf16x8*)(WaT + (size_t)ch * 128 + ks * 32 + quad * 8); wif[ks] = *(const GAS bf16x8*)(WiT + (size_t)ch * 128 + ks * 32 + quad * 8); }
    const float ba = inp(F, I_BRGA)[gc], bi = inp(F, I_BRGI)[gc];
    const float lam = inp(F, I_LAM)[gc];
    const float sp8 = 8.0f * log1pf(__expf(-lam));
    { const int cg = tid & 15, tq = tid >> 4, ch0 = h * HD + cg * 8;
      float cw[4][8], cb[8];
#pragma unroll
      for (int j = 0; j < 4; ++j) { const f32x4 a0 = *(const GAS f32x4*)(inp(F, I_CONVW) + j * RGW + ch0), a1 = *(const GAS f32x4*)(inp(F, I_CONVW) + j * RGW + ch0 + 4);
          cw[j][0] = a0[0]; cw[j][1] = a0[1]; cw[j][2] = a0[2]; cw[j][3] = a0[3]; cw[j][4] = a1[0]; cw[j][5] = a1[1]; cw[j][6] = a1[2]; cw[j][7] = a1[3]; }
      { const f32x4 a0 = *(const GAS f32x4*)(inp(F, I_CONVB) + ch0), a1 = *(const GAS f32x4*)(inp(F, I_CONVB) + ch0 + 4);
          cb[0] = a0[0]; cb[1] = a0[1]; cb[2] = a0[2]; cb[3] = a0[3]; cb[4] = a1[0]; cb[5] = a1[1]; cb[6] = a1[2]; cb[7] = a1[3]; }
      v4u raw[7];
#pragma unroll
      for (int r = 0; r < 7; ++r) { const int trow = c * 128 + tq * 4 - 3 + r;
          raw[r] = (trow >= 0) ? *(const GAS v4u*)(P + (size_t)(b * T + trow) * INC + ch0) : (v4u){0u, 0u, 0u, 0u}; }
#pragma unroll
      for (int tt = 0; tt < 4; ++tt) { float o[8];
#pragma unroll
          for (int e = 0; e < 8; ++e) o[e] = cb[e];
#pragma unroll
          for (int j = 0; j < 4; ++j) { const v4u rw = raw[tt + j];
              const float f[8] = {bflo(rw.x), bfhi(rw.x), bflo(rw.y), bfhi(rw.y), bflo(rw.z), bfhi(rw.z), bflo(rw.w), bfhi(rw.w)};
#pragma unroll
              for (int e = 0; e < 8; ++e) o[e] += cw[j][e] * f[e]; }
          v4u wv; wv.x = pk2(o[0], o[1]); wv.y = pk2(o[2], o[3]); wv.z = pk2(o[4], o[5]); wv.w = pk2(o[6], o[7]);
          *(LAS v4u*)(F.lds + (tq * 4 + tt) * XST + cg * 16) = wv; }
      if (FINAL) {
#pragma unroll
          for (int p = 0; p < 4; ++p) { const int idx = tid + 512 * p, row = idx >> 4, c16 = idx & 15;
              const v4u gvv = *(const GAS v4u*)(P + (size_t)(tok0 + row) * INC + RGW + h * HD + c16 * 8); *(LAS v4u*)(F.lds + GOFF + row * XST + c16 * 16) = gvv; } }
    }
    __syncthreads();
    f32x4 ar[8], ai[8];
#pragma unroll
    for (int tb = 0; tb < 8; ++tb) { ar[tb] = (f32x4){0.f, 0.f, 0.f, 0.f}; ai[tb] = (f32x4){0.f, 0.f, 0.f, 0.f};
#pragma unroll
        for (int ks = 0; ks < 4; ++ks) { const bf16x8 xf = *(const LAS bf16x8*)(F.lds + (tb * 16 + q) * XST + (ks * 32 + quad * 8) * 2);
            ar[tb] = __builtin_amdgcn_mfma_f32_16x16x32_bf16(xf, waf[ks], ar[tb], 0, 0, 0);
            ai[tb] = __builtin_amdgcn_mfma_f32_16x16x32_bf16(xf, wif[ks], ai[tb], 0, 0, 0); } }
#pragma unroll
    for (int tb = 0; tb < 8; ++tb)
#pragma unroll
        for (int tt = 0; tt < 4; ++tt) { const int t = tb * 16 + quad * 4 + tt;
            const float r = sigmoidf_(ar[tb][tt] + ba), ig = sigmoidf_(ai[tb][tt] + bi);
            const float la = -sp8 * r, a = __expf(la), t2 = 2.0f * la;
            const float om = (t2 > -0.05f) ? -t2 * (1.0f + t2 * (0.5f + t2 * (0.16666667f + t2 * 0.041666668f))) : 1.0f - __expf(t2);
            const float xcv = bf2f(*(const LAS bf16*)(F.lds + t * XST + ch * 2));
            ar[tb][tt] = a; ai[tb][tt] = __builtin_amdgcn_sqrtf(om) * ig * xcv; }
    float Pe[8], He[8], PB[8], HB[8]; float PC = 1.f, HC = 0.f;
#pragma unroll
    for (int tb = 0; tb < 8; ++tb) {
        const float a0 = ar[tb][0], a1 = ar[tb][1], a2 = ar[tb][2], a3 = ar[tb][3], u0 = ai[tb][0], u1 = ai[tb][1], u2 = ai[tb][2], u3 = ai[tb][3];
        float Pl = a0 * a1 * a2 * a3, Hl = ((u0 * a1 + u1) * a2 + u2) * a3 + u3;
        { const float Pp = __shfl_up(Pl, 16), Hp = __shfl_up(Hl, 16); if (quad >= 1) { Hl = Hp * Pl + Hl; Pl = Pp * Pl; } }
        { const float Pp = __shfl_up(Pl, 32), Hp = __shfl_up(Hl, 32); if (quad >= 2) { Hl = Hp * Pl + Hl; Pl = Pp * Pl; } }
        float pe = __shfl_up(Pl, 16), he = __shfl_up(Hl, 16); if (quad == 0) { pe = 1.f; he = 0.f; }
        Pe[tb] = pe; He[tb] = he; PB[tb] = __shfl(Pl, 48 + q); HB[tb] = __shfl(Hl, 48 + q);
        HC = HB[tb] + PB[tb] * HC; PC = PC * PB[tb];
    }
    if (quad == 0) {
        __hip_atomic_store(GA + (size_t)(b * NCHUNK + c) * RGW + gc, (1ull << 32) | (unsigned long long)__builtin_bit_cast(unsigned, PC), __ATOMIC_RELAXED, __HIP_MEMORY_SCOPE_AGENT);
        __hip_atomic_store(GH + (size_t)(b * NCHUNK + c) * RGW + gc, (1ull << 32) | (unsigned long long)__builtin_bit_cast(unsigned, HC), __ATOMIC_RELAXED, __HIP_MEMORY_SCOPE_AGENT); }
    float carry = 0.f;
    { unsigned* tmo = (unsigned*)(F.ws + WS_CTL) + 8; unsigned spins = 0;
#pragma unroll
      for (int base = 0; base < NCHUNK; base += 8) {
        if (base < c) { unsigned long long gA[8], gH[8];
            for (;;) { bool ok = true;
#pragma unroll
                for (int j = 0; j < 8; ++j) { const int cs = (base + j < c) ? base + j : c - 1;
                    gA[j] = __hip_atomic_load(GA + (size_t)(b * NCHUNK + cs) * RGW + gc, __ATOMIC_RELAXED, __HIP_MEMORY_SCOPE_AGENT);
                    gH[j] = __hip_atomic_load(GH + (size_t)(b * NCHUNK + cs) * RGW + gc, __ATOMIC_RELAXED, __HIP_MEMORY_SCOPE_AGENT);
                    ok = ok && ((gA[j] >> 32) == 1ull) && ((gH[j] >> 32) == 1ull); }
                if (__all(ok)) break;
                __builtin_amdgcn_s_sleep(2);
                if (++spins > (1u << 16)) { if (lane == 0) __hip_atomic_store(tmo, 1u, __ATOMIC_RELAXED, __HIP_MEMORY_SCOPE_AGENT); break; }
                if ((spins & 63u) == 0u && __hip_atomic_load(tmo, __ATOMIC_RELAXED, __HIP_MEMORY_SCOPE_AGENT) != 0u) break; }
#pragma unroll
            for (int j = 0; j < 8; ++j) if (base + j < c) carry = __builtin_bit_cast(float, (unsigned)gH[j]) + __builtin_bit_cast(float, (unsigned)gA[j]) * carry; } } }
#pragma unroll
    for (int tb = 0; tb < 8; ++tb) {
        const float a0 = ar[tb][0], a1 = ar[tb][1], a2 = ar[tb][2], a3 = ar[tb][3], u0 = ai[tb][0], u1 = ai[tb][1], u2 = ai[tb][2], u3 = ai[tb][3];
        float hp = He[tb] + Pe[tb] * carry;
        const float g0 = bf2f(*(const LAS bf16*)(F.lds + GOFF + (tb * 16 + quad * 4 + 0) * XST + ch * 2)), g1 = bf2f(*(const LAS bf16*)(F.lds + GOFF + (tb * 16 + quad * 4 + 1) * XST + ch * 2));
        const float g2 = bf2f(*(const LAS bf16*)(F.lds + GOFF + (tb * 16 + quad * 4 + 2) * XST + ch * 2)), g3 = bf2f(*(const LAS bf16*)(F.lds + GOFF + (tb * 16 + quad * 4 + 3) * XST + ch * 2));
        hp = a0 * hp + u0; *(LAS bf16*)(F.lds + YOFF + (tb * 16 + quad * 4 + 0) * XST + ch * 2) = (bf16)f2bf(g0 * hp);
        hp = a1 * hp + u1; *(LAS bf16*)(F.lds + YOFF + (tb * 16 + quad * 4 + 1) * XST + ch * 2) = (bf16)f2bf(g1 * hp);
        hp = a2 * hp + u2; *(LAS bf16*)(F.lds + YOFF + (tb * 16 + quad * 4 + 2) * XST + ch * 2) = (bf16)f2bf(g2 * hp);
        hp = a3 * hp + u3; *(LAS bf16*)(F.lds + YOFF + (tb * 16 + quad * 4 + 3) * XST + ch * 2) = (bf16)f2bf(g3 * hp);
        carry = HB[tb] + PB[tb] * carry;
    }
    {
        __syncthreads();
        float ssq = 0.f; const int row = tid >> 2, q4 = tid & 3;
#pragma unroll
        for (int p = 0; p < 4; ++p) { const int c16 = p * 4 + q4;     const v4u yv = *(const LAS v4u*)(F.lds + YOFF + row * XST + c16 * 16);
            *(GAS v4u*)(YB + (size_t)(tok0 + row) * D + h * HD + c16 * 8) = yv;
            const float f[8] = {bflo(yv.x), bfhi(yv.x), bflo(yv.y), bfhi(yv.y), bflo(yv.z), bfhi(yv.z), bflo(yv.w), bfhi(yv.w)};
#pragma unroll
            for (int e = 0; e < 8; ++e) ssq += f[e] * f[e]; }
        ssq += __shfl_xor(ssq, 1); ssq += __shfl_xor(ssq, 2);
        if (q4 == 0) atomicAdd(ssr + tok0 + row, (unsigned long long)(ssq * SS_SCALE + 0.5f));
    }
    __syncthreads();
}

__device__ __forceinline__ void router_phase(Frame& F) {
    const bf16* Hh = (const bf16*)(F.ws + WS_H); unsigned char* HN = F.ws + WS_HN; const float* WRP = (const float*)(F.ws + WS_WRP);
    int* TOPI = (int*)(F.ws + WS_TOPI); float* TOPG = (float*)(F.ws + WS_TOPG); float* RSTD = (float*)(F.ws + WS_RSTD);
    constexpr int PSZ = 8 * 32 * 33;
    LAS float* part = (LAS float*)F.lds;
    LAS float* ssqp = part + 4 * PSZ;
    LAS float* lg = ssqp + 4 * 256;
    const int w = F.wave, lane = F.lane, m = lane & 31, kk = lane >> 5;
    f32x4 bw[32];
#pragma unroll
    for (int i = 0; i < 32; ++i) bw[i] = *(const GAS f32x4*)(WRP + ((size_t)(64 * w + 32 * kk + i) * 32 + m) * 4);
    const int ntile = (NTOK / 32 - F.bx + F.G - 1) / F.G;
    for (int j0 = 0; j0 < ntile; j0 += 4) {
        const int nj = (ntile - j0) < 4 ? (ntile - j0) : 4;
        for (int ts = 0; ts < nj; ++ts) {
            const int tile = F.bx + F.G * (j0 + ts), tok0 = tile * 32;
            const bf16* hrow = Hh + (size_t)(tok0 + m) * D + 256 * w + 128 * kk;
            float ssq = 0.f;
            f32x16 acc;
#pragma unroll
            for (int r = 0; r < 16; ++r) acc[r] = 0.f;
            v4u a0[4], a1[4];
#pragma unroll
            for (int i = 0; i < 4; ++i) a0[i] = *(const GAS v4u*)(hrow + 8 * i);
#pragma unroll
            for (int ib = 0; ib < 4; ++ib) {
                if (ib < 3) {
#pragma unroll
                    for (int i = 0; i < 4; ++i) { if (ib & 1) a0[i] = *(const GAS v4u*)(hrow + 8 * (4 * (ib + 1) + i)); else a1[i] = *(const GAS v4u*)(hrow + 8 * (4 * (ib + 1) + i)); } }
#pragma unroll
                for (int i = 0; i < 4; ++i) { const v4u q = (ib & 1) ? a1[i] : a0[i];
                    const float av[8] = {bflo(q.x), bfhi(q.x), bflo(q.y), bfhi(q.y), bflo(q.z), bfhi(q.z), bflo(q.w), bfhi(q.w)};
#pragma unroll
                    for (int e = 0; e < 8; ++e) { ssq += av[e] * av[e]; acc = __builtin_amdgcn_mfma_f32_32x32x2f32(av[e], bw[ib * 8 + 2 * i + (e >> 2)][e & 3], acc, 0, 0, 0); } }
            }
            ssq += __shfl_xor(ssq, 32);
#pragma unroll
            for (int r = 0; r < 16; ++r) { const int mr = (r & 3) + 8 * (r >> 2) + 4 * kk; part[ts * PSZ + (w * 32 + mr) * 33 + m] = acc[r]; }
            if (lane < 32) ssqp[ts * 256 + w * 32 + m] = ssq;
        }
        for (int ts = 0; ts < nj; ++ts)
#pragma unroll 1
            for (int rr = 0; rr < 4; ++rr) { const int tok = (F.bx + F.G * (j0 + ts)) * 32 + 4 * w + rr;
                const bf16* hp = Hh + (size_t)tok * D + 32 * lane; float x[32];
#pragma unroll
                for (int i = 0; i < 4; ++i) { const v4u q = *(const GAS v4u*)(hp + 8 * i);
                    x[8 * i] = bflo(q.x); x[8 * i + 1] = bfhi(q.x); x[8 * i + 2] = bflo(q.y); x[8 * i + 3] = bfhi(q.y); x[8 * i + 4] = bflo(q.z); x[8 * i + 5] = bfhi(q.z); x[8 * i + 6] = bflo(q.w); x[8 * i + 7] = bfhi(q.w); }
                v4u lo, hi; pack_fp6(x, lo, hi);
                unsigned char* op = HN + (size_t)tok * D + 128 * (lane >> 2) + 16 * (lane & 3);
                *(GAS v4u*)op = lo; *(GAS v4u*)(op + 64) = hi; }
        __syncthreads();
        { const int tm = F.tid >> 2, e8 = (F.tid & 3) * 8, ts = tm >> 5, mm = tm & 31;
          if (ts < nj) {
            float sq = 0.f;
#pragma unroll
            for (int ww = 0; ww < 8; ++ww) sq += ssqp[ts * 256 + ww * 32 + mm];
            const float r = 1.0f / __builtin_sqrtf(sq * (1.0f / D) + EPS);
            float l[8];
#pragma unroll
            for (int e = 0; e < 8; ++e) l[e] = 0.f;
#pragma unroll
            for (int ww = 0; ww < 8; ++ww)
#pragma unroll
                for (int e = 0; e < 8; ++e) l[e] += part[ts * PSZ + (ww * 32 + mm) * 33 + e8 + e];
#pragma unroll
            for (int e = 0; e < 8; ++e) lg[tm * 33 + e8 + e] = l[e] * r + inp(F, I_BR)[e8 + e];
            if ((F.tid & 3) == 0) RSTD[(F.bx + F.G * (j0 + ts)) * 32 + mm] = r; } }
        __syncthreads();
        if (F.tid < 32 * nj) { const int tm = F.tid, ts = tm >> 5, mm = tm & 31; float v[32];
#pragma unroll
            for (int e = 0; e < 32; ++e) v[e] = lg[tm * 33 + e];
            int idx[4]; float val[4];
#pragma unroll
            for (int k = 0; k < 4; ++k) { float best = -3.0e38f; int bi = 0;
#pragma unroll
                for (int e = 0; e < 32; ++e) { const bool tk = v[e] > best; best = tk ? v[e] : best; bi = tk ? e : bi; }
                idx[k] = bi; val[k] = best;
#pragma unroll
                for (int e = 0; e < 32; ++e) v[e] = (e == bi) ? -3.0e38f : v[e]; }
            const float e0 = 1.0f, e1 = __expf(val[1] - val[0]), e2 = __expf(val[2] - val[0]), e3 = __expf(val[3] - val[0]);
            const float inv = 1.0f / (e0 + e1 + e2 + e3);
            const int tok = (F.bx + F.G * (j0 + ts)) * 32 + mm;
            *(GAS i32x4*)(TOPI + tok * 4) = (i32x4){idx[0], idx[1], idx[2], idx[3]};
            *(GAS f32x4*)(TOPG + tok * 4) = (f32x4){e0 * inv, e1 * inv, e2 * inv, e3 * inv};
            if (!F.rep)
#pragma unroll
            for (int k = 0; k < 4; ++k) (void)__hip_atomic_fetch_add((LAS unsigned*)(F.lds + LDSCTL_OFF) + LC_HIST + idx[k], 1u, __ATOMIC_RELAXED, __HIP_MEMORY_SCOPE_WORKGROUP);
        }
        __syncthreads();
    }
}

__device__ __forceinline__ void scatter_phase(Frame& F) {
    const int* CNT = (const int*)(F.ws + WS_CNTWG); const int* TOPI = (const int*)(F.ws + WS_TOPI); const float* TOPG = (const float*)(F.ws + WS_TOPG);
    int* INV = (int*)(F.ws + WS_INV); int* TOKS = (int*)(F.ws + WS_TOKS); float* GATES = (float*)(F.ws + WS_GATES); int* META = (int*)(F.ws + WS_META);
    const float* RSTD = (const float*)(F.ws + WS_RSTD); float* RSS = (float*)(F.ws + WS_RSS);
    LAS int* red = (LAS int*)F.lds;
    { const int e = F.tid & 31, part = F.tid >> 5; int sb = 0, sa = 0;
      for (int wg = part; wg < F.G; wg += 16) { const int v = CNT[wg * 32 + e]; sa += v; sb += (wg < F.bx) ? v : 0; }
      red[part * 32 + e] = sb; red[512 + part * 32 + e] = sa; }
    __syncthreads();
    if (F.tid < 32) { int sb = 0, sa = 0;
#pragma unroll
        for (int p = 0; p < 16; ++p) { sb += red[p * 32 + F.tid]; sa += red[512 + p * 32 + F.tid]; }
        F.LC[LC_BASE + F.tid] = (unsigned)sb; F.LC[LC_TOTAL + F.tid] = (unsigned)sa; }
    __syncthreads();
    if (F.tid == 0) { int acc = 0; for (int e = 0; e < NE; ++e) { F.LC[LC_TPRE + e] = (unsigned)acc; acc += ((int)F.LC[LC_TOTAL + e] + 255) >> 8; } F.LC[LC_TPRE + NE] = (unsigned)acc; }
    __syncthreads();
    if (F.bx == 0 && F.tid <= NE) META[F.tid] = (int)F.LC[LC_TPRE + F.tid];
    LAS int* wcnt = red;
    const int lane = F.lane, w = F.wave;
    const int ntile = (NTOK / 32 - F.bx + F.G - 1) / F.G;
    for (int j0 = 0; j0 < ntile; j0 += 4) {
        const int j = j0 + (F.tid >> 7), i = F.tid & 127, tile = F.bx + F.G * j;
        const bool valid = j < ntile;
        const int e = valid ? TOPI[tile * 128 + i] : -1;
        float gt = 0.f, rsd = 0.f; if (valid) { gt = TOPG[tile * 128 + i]; rsd = RSTD[tile * 32 + (i >> 2)]; }
        unsigned long long mine = 0ull; int cnt_e = 0;
#pragma unroll
        for (int x = 0; x < NE; ++x) { const unsigned long long m = __ballot(e == x); mine = (e == x) ? m : mine; cnt_e = (lane == x) ? __popcll(m) : cnt_e; }
        const int rank = __popcll(mine & ((1ull << lane) - 1ull));
        __syncthreads();
        if (lane < NE) wcnt[w * 32 + lane] = cnt_e;
        __syncthreads();
        if (F.tid < NE) { int acc = 0;
#pragma unroll
            for (int ww = 0; ww < 8; ++ww) { const int c = wcnt[ww * 32 + F.tid]; wcnt[ww * 32 + F.tid] = acc; acc += c; }
            wcnt[256 + F.tid] = acc; }
        __syncthreads();
        if (valid) { const int pos = 256 * (int)F.LC[LC_TPRE + e] + (int)F.LC[LC_BASE + e] + wcnt[w * 32 + e] + rank;
            TOKS[pos] = tile * 32 + (i >> 2); GATES[pos] = gt; RSS[pos] = rsd; INV[tile * 128 + i] = pos; }
        __syncthreads();
        if (F.tid < NE) F.LC[LC_BASE + F.tid] += (unsigned)wcnt[256 + F.tid];
    }
    __syncthreads();
    if (F.bx < NE) { const int e = F.bx, tot = (int)F.LC[LC_TOTAL + e], r0 = 256 * (int)F.LC[LC_TPRE + e], r1 = 256 * (int)F.LC[LC_TPRE + e + 1];
        for (int r = r0 + tot + F.tid; r < r1; r += 512) { TOKS[r] = 0; GATES[r] = 0.f; RSS[r] = 0.f; } }
}

__device__ __forceinline__ void final_row(Frame& F, float* outp, int tok) {
    const bf16* Hh = (const bf16*)(F.ws + WS_H); const unsigned char* YS = F.ws + WS_YS; const int* INV = (const int*)(F.ws + WS_INV);
    const int lane = F.lane;
    const i32x4 pos = *(const GAS i32x4*)(INV + tok * 4);
    const GAS v2u* hr = (const GAS v2u*)(Hh + (size_t)tok * D) + lane;
    const GAS unsigned* y0 = (const GAS unsigned*)(YS + (size_t)pos.x * D) + lane; const GAS unsigned* y1 = (const GAS unsigned*)(YS + (size_t)pos.y * D) + lane;
    const GAS unsigned* y2 = (const GAS unsigned*)(YS + (size_t)pos.z * D) + lane; const GAS unsigned* y3 = (const GAS unsigned*)(YS + (size_t)pos.w * D) + lane;
    f32x4 v[8]; float s = 0.f;
#pragma unroll
    for (int j = 0; j < 8; ++j) { const v2u hq_ = hr[64 * j]; const f32x4 hv = {bflo(hq_.x), bfhi(hq_.x), bflo(hq_.y), bfhi(hq_.y)}; const unsigned a = y0[64 * j], b = y1[64 * j], c = y2[64 * j], d = y3[64 * j];
        const f32x2 a0 = __builtin_amdgcn_cvt_pk_f32_fp8((int)a, false), a1 = __builtin_amdgcn_cvt_pk_f32_fp8((int)a, true), b0 = __builtin_amdgcn_cvt_pk_f32_fp8((int)b, false), b1 = __builtin_amdgcn_cvt_pk_f32_fp8((int)b, true);
        const f32x2 c0 = __builtin_amdgcn_cvt_pk_f32_fp8((int)c, false), c1 = __builtin_amdgcn_cvt_pk_f32_fp8((int)c, true), d0 = __builtin_amdgcn_cvt_pk_f32_fp8((int)d, false), d1 = __builtin_amdgcn_cvt_pk_f32_fp8((int)d, true);
        f32x4 mo;
        mo[0] = ((a0[0] + b0[0]) + c0[0]) + d0[0]; mo[1] = ((a0[1] + b0[1]) + c0[1]) + d0[1];
        mo[2] = ((a1[0] + b1[0]) + c1[0]) + d1[0]; mo[3] = ((a1[1] + b1[1]) + c1[1]) + d1[1];
        v[j] = hv + mo * 0.0625f; s += (v[j][0] * v[j][0] + v[j][1] * v[j][1]) + (v[j][2] * v[j][2] + v[j][3] * v[j][3]); }
    const float r = 1.0f / __builtin_sqrtf(wave_sum(s) * (1.0f / D) + EPS);
    GAS f32x4* o = (GAS f32x4*)(outp + (size_t)tok * D) + lane;
#pragma unroll
    for (int j = 0; j < 8; ++j) { const f32x4 gg = ((const GAS f32x4*)inp(F, I_FING))[lane + 64 * j]; o[64 * j] = v[j] * r * gg; }
}

__device__ __forceinline__ void ph1_gemms(Frame& F) {
    { pg8::DenseOrder S; S.init(NTOK, INC, F.G, F.bx, (const bf16*)(F.ws + WS_WIN));
      LAS float* rsl = (LAS float*)(F.lds + pg8::STAGE_BYTES);
      { const float* rs0 = (const float*)(F.ws + WS_RSTD0); int nu = 0; pg8::Unit u;
        while (nu < 28 && S.next(nu, u)) { if (F.tid < 256) rsl[nu * 256 + F.tid] = rs0[u.pm * 256 + F.tid]; ++nu; }
        __syncthreads(); }
      pg8::EpiInProj E{(bf16*)(F.ws + WS_P), 0.08838834764831845f * 1.4426950408889634f, (const LAS float*)rsl};
      pg8::gemm_phase<0>(F.lds, F.ws + WS_XB, S, E, F.wave); }
    { pg8::DenseSplit8 S; S.init(NB * MEM, XAW, F.G, F.bx, (const bf16*)(F.ws + WS_WKT));
      pg8::EpiPartialF32 E{(bf16*)(F.ws + WS_KVP), 512, (size_t)NB * MEM * XAW};
      pg8::gemm_phase<0, 8>(F.lds, F.ws + WS_MEMN, S, E, F.wave); }
    { pg8::DenseSplit8 S; S.init(XAW, NB * MEM, F.G, (F.bx + F.G - 128 % F.G) % F.G, (const bf16*)(F.ws + WS_MEMN));
      pg8::EpiPartialF32 E{(bf16*)(F.ws + WS_KVP) + (size_t)8 * NB * MEM * XAW, 2048, (size_t)NB * MEM * XAW};
      pg8::gemm_phase<0, 8>(F.lds, F.ws + WS_WVT, S, E, F.wave); }
}
#ifndef P2_MASK
#define P2_MASK 7
#endif
#ifndef REP_P2MASK
#define REP_P2MASK 7
#endif
__device__ __forceinline__ void ph2_mixers(Frame& F) {
    { const bf16* KVP = (const bf16*)(F.ws + WS_KVP); bf16* KB = (bf16*)(F.ws + WS_KB); bf16* VT = (bf16*)(F.ws + WS_VT);
      constexpr int NOUT4 = NB * MEM * XAW / 4;
      for (int i = F.bx * 512 + F.tid; i < 2 * NOUT4; i += F.G * 512) { const int t = i >= NOUT4, j = t ? i - NOUT4 : i;
          const bf16* p = KVP + (size_t)t * 8 * NB * MEM * XAW + (size_t)j * 4; f32x4 a = {0.f, 0.f, 0.f, 0.f};
#pragma unroll
          for (int k = 0; k < 8; ++k) { const v2u q = *(const GAS v2u*)(p + (size_t)k * NB * MEM * XAW); a = a + (f32x4){bflo(q.x), bfhi(q.x), bflo(q.y), bfhi(q.y)}; }
          v2u o; o.x = pk2(a[0], a[1]); o.y = pk2(a[2], a[3]); *(GAS v2u*)((t ? VT : KB) + (size_t)j * 4) = o; } }
    const int pmask = F.rep ? REP_P2MASK : P2_MASK;
    if (pmask & 2) for (int u = F.bx; u < NB * NCHUNK; u += F.G) gmlp_unit(F, u >> 5, u & 31);
    if (pmask & 4) for (int u = F.bx; u < NB * NCHUNK * 8; u += F.G) rg_unit_lb(F, u >> 8, (u >> 3) & 31, u & 7);
}
__device__ __forceinline__ void ph3_rg_final(Frame& F) {
    if (P2_MASK & 1) for (int u = F.bx; u < NB * 4 * 8; u += F.G) xattn_unit(F, u >> 5, (u >> 3) & 3, u & 7);
}
__device__ __forceinline__ void ph4_outproj(Frame& F) {
    pg8::DenseOrder S; S.init(NTOK, D, F.G, F.bx, (const bf16*)(F.ws + WS_WOUT));
    const unsigned long long* ssp = (const unsigned long long*)(F.ws + CTL_SS);
    LAS float* fac = (LAS float*)(F.lds + pg8::STAGE_BYTES);
    int nu = 0; { pg8::Unit u; while (nu < 10 && S.next(nu, u)) ++nu; }
    for (int i = 0; i < nu; ++i) { pg8::Unit u; (void)S.next(i, u);
        if (F.tid < 256) { const int r = u.pm * 256 + F.tid; const float rg = (float)ssp[r], gm = (float)ssp[NTOK + r], xa = (float)ssp[2 * NTOK + r];
            fac[(i * 256 + F.tid) * 3 + 0] = __builtin_sqrtf((gm * (SS_INV / GMW) + EPS) / (rg * (SS_INV / RGW) + EPS));
            fac[(i * 256 + F.tid) * 3 + 1] = __builtin_sqrtf((xa * (SS_INV / XAW) + EPS) / (gm * (SS_INV / GMW) + EPS));
            fac[(i * 256 + F.tid) * 3 + 2] = 0.f; } }
    __syncthreads();
    pg8::EpiOutProj E{(const bf16*)(F.ws + WS_XB), (bf16*)(F.ws + WS_H), ssp, (const LAS float*)fac};
    pg8::gemm_phase<0>(F.lds, F.ws + WS_YBUF, S, E, F.wave);
}
__device__ __forceinline__ void ph5_router(Frame& F) {
    router_phase(F);
    if (F.tid < NE && !F.rep) ((int*)(F.ws + WS_CNTWG))[F.bx * 32 + F.tid] = (int)F.LC[LC_HIST + F.tid];
}
__device__ __forceinline__ void ph7_gateup(Frame& F) {
    if (F.tid <= NE) F.LC[LC_TPRE + F.tid] = (unsigned)((const int*)(F.ws + WS_META))[F.tid];
    __syncthreads();
    pg8::GroupedOrder<true> S; S.nM = (int)F.LC[LC_TPRE + NE]; S.nN = 16; S.G = F.G; S.c = F.bx; S.Bt = F.ws + WS_WGU; S.tok = (const int*)(F.ws + WS_TOKS); S.tpre = (const volatile LAS int*)(F.LC + LC_TPRE);
    pg8::EpiGateUp E{F.ws + WS_ACT, inp(F, I_BGU), (const float*)(F.ws + WS_RSS), F.lds + pg8::STAGE_BYTES};
    pg8::gemm_phase<2>(F.lds, F.ws + WS_HN, S, E, F.wave);
}
__device__ __forceinline__ void ph8_down(Frame& F) {
    if (F.tid <= NE) F.LC[LC_TPRE + F.tid] = (unsigned)((const int*)(F.ws + WS_META))[F.tid];
    __syncthreads();
    pg8::GroupedOrder<false> S; S.nM = (int)F.LC[LC_TPRE + NE]; S.nN = 8; S.G = F.G; S.c = F.bx; S.Bt = F.ws + WS_WD; S.tok = nullptr; S.tpre = (const volatile LAS int*)(F.LC + LC_TPRE);
    pg8::EpiDown E{F.ws + WS_YS, inp(F, I_BD), (const float*)(F.ws + WS_GATES), F.lds + pg8::STAGE_BYTES};
    pg8::gemm_phase<1>(F.lds, F.ws + WS_ACT, S, E, F.wave);
}
__device__ __forceinline__ void ph9_final(Frame& F) {
    const int gw = F.bx * 8 + F.wave, NGW = F.G * 8;
    float* outp = (float*)inp(F, 27);
    for (int tok = gw; tok < NTOK; tok += NGW) final_row(F, outp, tok);
}

constexpr int NPH = 10;
struct Args { const float* in[27]; float* out; unsigned char* ws; int ph_lo, ph_hi; };
__global__ void __launch_bounds__(512, 2) mk_fwd(Args args) {
    extern __shared__ __attribute__((aligned(16))) unsigned char lds[];
    Frame F;
    F.lds = (LAS unsigned char*)lds;
    F.LC = (volatile LAS unsigned*)(F.lds + LDSCTL_OFF);
    F.wave = __builtin_amdgcn_readfirstlane((int)threadIdx.x >> 6); F.lane = lane_id(); F.tid = F.wave * 64 + F.lane;
    F.G = gridDim.x; F.bx = blockIdx.x; F.ws = args.ws; F.rep = 0;
    for (int u = F.tid; u < (LDS_BYTES - LDSCTL_OFF) / 4; u += 512) F.LC[u] = 0u;
    __syncthreads();
    if (F.tid == 27) { const unsigned long long pv = (unsigned long long)args.out; F.LC[LC_PTR + 54] = (unsigned)pv; F.LC[LC_PTR + 55] = (unsigned)(pv >> 32); }
    if (F.tid < 27) { const unsigned long long pv = (unsigned long long)args.in[F.tid]; F.LC[LC_PTR + 2 * F.tid] = (unsigned)pv; F.LC[LC_PTR + 2 * F.tid + 1] = (unsigned)(pv >> 32); }
    __syncthreads();
    const int lo = args.ph_lo, hi = args.ph_hi;
    XcdBarrier bar; bar.bar = (unsigned*)(F.ws + WS_CTL) + CW_BAR; bar.x = 0; bar.st = F.LC + LC_BAR; bar.wave = F.wave;
    if (hi - lo > 1) bar = xcd_barrier_post((unsigned*)(F.ws + WS_CTL) + CW_BAR, F.LC + LC_BAR, F.wave);
#ifndef PH_MASK
#define PH_MASK 0x3ff
#endif
#define IN(k) (((PH_MASK >> (k)) & 1) && lo <= (k) && (k) < hi)
#define SEAM(k) do { if (IN(k) && IN((k) + 1)) xcd_barrier(bar); } while (0)

#define RUN(k, ...) do { if (IN(k)) { F.rep = 0; { int l_ = lane_id(); asm volatile("" : "+v"(l_)); F.lane = l_; F.tid = F.wave * 64 + l_; }     __VA_ARGS__; if (REP_PHASE == (k)) { xcd_barrier(bar); F.rep = 1; __VA_ARGS__; } } } while (0)
    RUN(0, p0_prologue(F));
    SEAM(0);
    RUN(1, ph1_gemms(F));
    SEAM(1);
    RUN(2, ph2_mixers(F));
    SEAM(2);
    RUN(3, ph3_rg_final(F));
    SEAM(3);
    RUN(4, ph4_outproj(F));
    SEAM(4);
    RUN(5, ph5_router(F));
    SEAM(5);
    RUN(6, scatter_phase(F));
    SEAM(6);
    RUN(7, ph7_gateup(F));
    SEAM(7);
    RUN(8, ph8_down(F));
    SEAM(8);
    RUN(9, ph9_final(F));
#undef IN
#undef SEAM
}

extern "C" void kernel_launch(void* const* d_in, const int* in_sizes, int n_in, void* d_out, int out_size, void* d_ws, size_t ws_size, hipStream_t stream) {
    static int grid = 0;
    if (grid == 0) {
        if (n_in != 27 || out_size != NTOK * D || ws_size < WS_END) { fprintf(stderr, "kernel_launch: unexpected shapes (n_in %d, out %d, ws %zu)\n", n_in, out_size, ws_size); grid = -1; return; }
        int dev = 0, cus = 0, per_cu = 0;
        if (hipGetDevice(&dev) != hipSuccess || hipDeviceGetAttribute(&cus, hipDeviceAttributeMultiprocessorCount, dev) != hipSuccess) { grid = -1; return; }
        if (hipFuncSetAttribute((const void*)mk_fwd, hipFuncAttributeMaxDynamicSharedMemorySize, LDS_BYTES) != hipSuccess) { fprintf(stderr, "kernel_launch: hipFuncSetAttribute failed\n"); grid = -1; return; }
        if (hipOccupancyMaxActiveBlocksPerMultiprocessor(&per_cu, (const void*)mk_fwd, 512, LDS_BYTES) != hipSuccess || per_cu < 1) { fprintf(stderr, "kernel_launch: occupancy query says %d\n", per_cu); }
        (void)hipGetLastError();
        grid = cus;
    }
    if (grid < 0) return;
    (void)hipMemsetAsync((char*)d_ws + WS_CTL, 0, CTL_ZERO_BYTES, stream);
    Args a{};
    for (int i = 0; i < 27; ++i) a.in[i] = (const float*)d_in[i];
    a.out = (float*)d_out; a.ws = (unsigned char*)d_ws;
#if MK_ONE_LAUNCH
    a.ph_lo = 0; a.ph_hi = NPH;
    hipLaunchKernelGGL(mk_fwd, dim3(grid), dim3(512), LDS_BYTES, stream, a);
#else
    for (int ph = 0; ph < NPH; ++ph) { a.ph_lo = ph; a.ph_hi = ph + 1; hipLaunchKernelGGL(mk_fwd, dim3(grid), dim3(512), LDS_BYTES, stream, a); }
#endif
}
```

```cpp
#include <hip/hip_runtime.h>
#include <cstdio>
#include <cstdint>

#ifndef REP_PHASE
#define REP_PHASE -1
#endif
#ifndef MK_ONE_LAUNCH
#define MK_ONE_LAUNCH 1
#endif

#define GAS __attribute__((address_space(1)))
#define LAS __attribute__((address_space(3)))
typedef unsigned short bf16;
typedef unsigned v4u __attribute__((ext_vector_type(4)));
typedef unsigned v2u __attribute__((ext_vector_type(2)));
typedef float f32x4 __attribute__((ext_vector_type(4)));
typedef float f32x2 __attribute__((ext_vector_type(2)));
typedef float f32x16 __attribute__((ext_vector_type(16)));
typedef short bf16x8 __attribute__((ext_vector_type(8)));
typedef int i32x4 __attribute__((ext_vector_type(4)));
typedef int i32x8 __attribute__((ext_vector_type(8)));
typedef int i32x6 __attribute__((ext_vector_type(6)));
typedef unsigned u32x6 __attribute__((ext_vector_type(6)));

constexpr int D = 2048, NB = 8, T = 4096, NTOK = NB * T;
constexpr int INC = 3584, RGW = 1024, GMW = 512, XAW = 512, HD = 128;
constexpr int NE = 32, TOPK = 4, MEM = 256;
constexpr int NASSIGN = NTOK * TOPK;
constexpr int MAXROWS = NASSIGN + NE * 256;
constexpr float EPS = 1e-6f;
constexpr int NCHUNK = T / 128;

constexpr size_t MiB = 1u << 20;
constexpr size_t WS_CTL = 0, CTL_ZERO_BYTES = 1 * MiB;
constexpr size_t CTL_SS = 128 * 1024;
constexpr float SS_SCALE = 1048576.0f, SS_INV = 1.0f / 1048576.0f;
constexpr size_t WS_WIN = 1 * MiB;
constexpr size_t WS_WOUT = 16 * MiB;
constexpr size_t WS_WKT = 24 * MiB;
constexpr size_t WS_WVT = 26 * MiB;
constexpr size_t WS_WA = 28 * MiB;
constexpr size_t WS_WI = WS_WA + 256 * 1024;
constexpr size_t WS_WSP = WS_WI + 256 * 1024;
constexpr size_t WS_WRP = WS_WSP + 128 * 1024;
constexpr size_t WS_MEMN = 30 * MiB;
constexpr size_t WS_KB = 38 * MiB;
constexpr size_t WS_VT = 40 * MiB;
constexpr size_t WS_CARRY = 42 * MiB;
constexpr size_t WS_TOPI = 44 * MiB;
constexpr size_t WS_TOPG = WS_TOPI + 512 * 1024;
constexpr size_t WS_INV = WS_TOPG + 512 * 1024;
constexpr size_t WS_CNTWG = WS_INV + 512 * 1024;
constexpr size_t WS_META = WS_CNTWG + 128 * 1024;
constexpr size_t WS_RSTD = WS_META + 4096;
constexpr size_t WS_RSS = 49 * MiB;
constexpr size_t WS_TOKS = 46 * MiB;
constexpr size_t WS_GATES = 47 * MiB;
constexpr size_t WS_DUMMY = 48 * MiB;
constexpr size_t WS_GRAN = 50 * MiB;
constexpr size_t WS_RSTD0 = 56 * MiB;
constexpr size_t WS_XB = 64 * MiB;
constexpr size_t WS_P = 192 * MiB;
constexpr size_t WS_YBUF = 416 * MiB;
constexpr size_t WS_H = 544 * MiB;
constexpr size_t WS_HN = 800 * MiB;
constexpr size_t WS_WGU = 1024 * MiB;
constexpr size_t WS_WD = 1536 * MiB;
constexpr size_t WS_ACT = 1792 * MiB;
constexpr size_t WS_YS = 2336 * MiB;
constexpr size_t WS_KVP = 2880 * MiB;
constexpr size_t WS_END = 2944 * MiB;
constexpr int CW_BAR = 4096;

constexpr int LDS_BYTES = 163840;
constexpr int LDSCTL_OFF = 162816;
constexpr int LC_BAR = 0;
constexpr int LC_TPRE = 8;
constexpr int LC_HIST = 48;
constexpr int LC_BASE = 80;
constexpr int LC_TOTAL = 112;
constexpr int LC_PTR = 160;

#define LDS_WAIT() asm volatile("s_waitcnt lgkmcnt(0)" ::: "memory")
#define VM_WAIT() asm volatile("s_waitcnt vmcnt(0)" ::: "memory")

__device__ __forceinline__ unsigned f2bf(float f) { unsigned u = __builtin_bit_cast(unsigned, f); return (u + 0x7fffu + ((u >> 16) & 1u)) >> 16; }
__device__ __forceinline__ unsigned pk2(float lo, float hi) { return f2bf(lo) | (f2bf(hi) << 16); }
__device__ __forceinline__ float bflo(unsigned w) { return __builtin_bit_cast(float, w << 16); }
__device__ __forceinline__ float bfhi(unsigned w) { return __builtin_bit_cast(float, w & 0xffff0000u); }
__device__ __forceinline__ float bf2f(bf16 b) { return __builtin_bit_cast(float, (unsigned)b << 16); }
__device__ __forceinline__ unsigned pk4_fp8(float a, float b, float c, float d) {
    a = fminf(fmaxf(a, -448.f), 448.f); b = fminf(fmaxf(b, -448.f), 448.f); c = fminf(fmaxf(c, -448.f), 448.f); d = fminf(fmaxf(d, -448.f), 448.f);
    int r = __builtin_amdgcn_cvt_pk_fp8_f32(a, b, 0, false);
    r = __builtin_amdgcn_cvt_pk_fp8_f32(c, d, r, true);
    return (unsigned)r;
}
__device__ __forceinline__ unsigned pk4_fp8_sc(float a, float b, float c, float d) {
    a = __builtin_amdgcn_fmed3f(a, -448.f, 448.f); b = __builtin_amdgcn_fmed3f(b, -448.f, 448.f); c = __builtin_amdgcn_fmed3f(c, -448.f, 448.f); d = __builtin_amdgcn_fmed3f(d, -448.f, 448.f);
    int r = __builtin_amdgcn_cvt_pk_fp8_f32(a, b, 0, false);
    r = __builtin_amdgcn_cvt_pk_fp8_f32(c, d, r, true);
    return (unsigned)r;
}
__device__ __forceinline__ void pack_fp6(const float (&v)[32], v4u& lo, v4u& hi) {
    float am = 0.f;
#pragma unroll
    for (int e = 0; e < 32; ++e) am = fmaxf(am, __builtin_fabsf(v[e]));
    unsigned eb = (__builtin_bit_cast(unsigned, am) >> 23) & 0xffu; eb = eb < 3u ? 3u : (eb > 250u ? 250u : eb);
    const unsigned sb = eb - 2u;
    const float inv = __builtin_bit_cast(float, (254u - sb) << 23);
    f32x16 a, b;
#pragma unroll
    for (int e = 0; e < 16; ++e) { a[e] = v[e] * inv; b[e] = v[16 + e] * inv; }
    const u32x6 d = __builtin_amdgcn_cvt_scalef32_2xpk16_fp6_f32(a, b, 1.0f);
    lo = (v4u){d[0], d[1], d[2], d[3]}; hi = (v4u){d[4], d[5], sb, 0u};
}
__device__ __forceinline__ int lane_id() { int l; asm volatile("v_mbcnt_lo_u32_b32 %0, -1, 0\n\tv_mbcnt_hi_u32_b32 %0, -1, %0" : "=v"(l)); return l; }
__device__ __forceinline__ float wave_sum(float v) {
#pragma unroll
    for (int o = 1; o < 64; o <<= 1) v += __shfl_xor(v, o);
    return v;
}
__device__ __forceinline__ float fast_exp2(float x) { return __builtin_amdgcn_exp2f(x); }
__device__ __forceinline__ float fast_rcp(float x) { return __builtin_amdgcn_rcpf(x); }
__device__ __forceinline__ float sigmoidf_(float z) { return fast_rcp(1.0f + fast_exp2(-1.4426950409f * z)); }
__device__ __forceinline__ float gelu_tanh(float x) { const float u = x + 0.044715f * x * x * x; return x * fast_rcp(1.0f + fast_exp2(-2.3022082f * u)); }

#define XB_TMO      128
#define XB_XCNT(j)  (256  + 64 * (j))
#define XB_XSUB(j)  (1280 + 64 * (j))
#define XB_XGEN(j)  (2304 + 64 * (j))
#define XB_TOP      3328
#define XB_TOPGEN   3392
#define XCD_BAR_WORDS 3456
#define XB_SPIN_CAP (1u << 18)
__device__ __forceinline__ unsigned xb_ld(unsigned* p)              { return __hip_atomic_load(p, __ATOMIC_RELAXED, __HIP_MEMORY_SCOPE_AGENT); }
__device__ __forceinline__ unsigned xb_add(unsigned* p, unsigned v) { return __hip_atomic_fetch_add(p, v, __ATOMIC_RELAXED, __HIP_MEMORY_SCOPE_AGENT); }
__device__ __forceinline__ unsigned xb_xcc_id() { return (unsigned)__builtin_amdgcn_s_getreg((3 << 11) | 20) & 0xFu; }
#define XB_SPIN(cond, bar) do { unsigned _sp = 0; while (cond) { __builtin_amdgcn_s_sleep(1); \
    if ((++_sp & 255u) == 0u) { if (xb_ld(&(bar)[XB_TMO])) break; if (_sp > XB_SPIN_CAP) { atomicAdd(&(bar)[XB_TMO], 1u); break; } } } } while (0)
struct XcdBarrier { unsigned* bar; unsigned x; volatile LAS unsigned* st; int wave; };
__device__ __forceinline__ XcdBarrier xcd_barrier_post(unsigned* bar, volatile LAS unsigned* st, int wave) {
    XcdBarrier b; b.bar = bar; b.x = xb_xcc_id(); b.st = st; b.wave = wave;
    if (wave == 0 && lane_id() == 0) (void)xb_add(&bar[XB_XCNT(b.x)], 1u);
    return b;
}
__device__ __forceinline__ void xcd_barrier_complete(unsigned* bar, unsigned x, unsigned& nloc, unsigned& nx) {
    const unsigned G = gridDim.x * gridDim.y * gridDim.z;
    unsigned sum, cnt, mine, sp = 0u;
    for (;;) {
        sum = 0u; cnt = 0u; mine = 0u;
#pragma unroll
        for (unsigned j = 0; j < 16; ++j) { const unsigned c = xb_ld(&bar[XB_XCNT(j)]); sum += c; cnt += (c > 0u) ? 1u : 0u; mine = (j == x) ? c : mine; }
        if (sum == G) break;
        __builtin_amdgcn_s_sleep(1);
        if ((++sp & 255u) == 0u) { if (xb_ld(&bar[XB_TMO])) break; if (sp > XB_SPIN_CAP) { atomicAdd(&bar[XB_TMO], 1u); break; } }
    }
    nloc = mine > 0u ? mine : 1u; nx = cnt > 0u ? cnt : 1u;
}
__device__ __forceinline__ void xcd_barrier(const XcdBarrier& b) {
    asm volatile("s_waitcnt vmcnt(0)" ::: "memory");
    __syncthreads();
    if (b.wave == 0 && lane_id() == 0) {
        unsigned* bar = b.bar;
        __builtin_amdgcn_s_waitcnt(0);
        unsigned nloc = b.st[0], nx = b.st[1];
        if (nloc == 0u) { xcd_barrier_complete(bar, b.x, nloc, nx); b.st[0] = nloc; b.st[1] = nx; }
        const unsigned old = xb_add(&bar[XB_XSUB(b.x)], 1u);
        const unsigned gen = old / nloc;
        if (old + 1u == (gen + 1u) * nloc) {
            __builtin_amdgcn_fence(__ATOMIC_RELEASE, "agent");
            asm volatile("s_waitcnt vmcnt(0)" ::: "memory");
            const unsigned og = xb_add(&bar[XB_TOP], 1u);
            const unsigned tg = og / nx;
            if (og + 1u == (tg + 1u) * nx) xb_add(&bar[XB_TOPGEN], 1u);
            else XB_SPIN(xb_ld(&bar[XB_TOPGEN]) == tg, bar);
            __builtin_amdgcn_fence(__ATOMIC_ACQUIRE, "agent");
            xb_add(&bar[XB_XGEN(b.x)], 1u);
            asm volatile("s_waitcnt vmcnt(0)" ::: "memory");
        } else {
            XB_SPIN(xb_ld(&bar[XB_XGEN(b.x)]) == gen, bar);
            __builtin_amdgcn_fence(__ATOMIC_ACQUIRE, "agent");
            asm volatile("s_waitcnt vmcnt(0)" ::: "memory");
        }
    }
    __syncthreads();
}

namespace pg8 {
constexpr int BM = 256, BK = 64, HALF = 128, HTB = HALF * BK * 2, STAGE_BYTES = 8 * HTB, NXCD = 8, WGM = 8;
constexpr int K = 2048;
__host__ __device__ __forceinline__ int lds_byte(int r, int c) { const int st = (r >> 4) * 2 + (c >> 5), rr = r & 15, cc = c & 31, ob = rr * 64 + cc * 2; return st * 1024 + (ob ^ (((ob >> 9) & 1) << 5)); }
__host__ __device__ __forceinline__ void stage_rc(int b, int& R, int& C) { const int st = b / 1024, sb = b % 1024, swz = sb ^ (((sb >> 9) & 1) << 5); R = (st >> 1) * 16 + swz / 64; C = (st & 1) * 32 + (swz % 64) / 2; }
__host__ __device__ __forceinline__ int perm32(int rho) { const int n = rho >> 4, i = rho & 15; return 8 * (i >> 2) + 4 * n + (i & 3); }

struct Unit { int pm, pn, e; };

__device__ __forceinline__ bool tile_order(int i, int G, int c, int nM, int nN, int& pm, int& pn) {
    const int nwg = nM * nN; const long L = (long)i * G + c; if (L >= nwg) return false;
    int wgid = (int)L; { const int q = nwg / NXCD, r = nwg % NXCD, xcd = wgid % NXCD, off = wgid / NXCD; wgid = (xcd < r ? xcd * (q + 1) : r * (q + 1) + (xcd - r) * q) + off; }
    const int nig = WGM * nN, gid = wgid / nig, fm = gid * WGM, gsz = (nM - fm) < WGM ? (nM - fm) : WGM;
    pm = fm + ((wgid % nig) % gsz); pn = (wgid % nig) / gsz; return true;
}
struct DenseOrder {
    static constexpr int KB = K * 2;
    int nM, nN, G, c; const bf16* Bt;
    __device__ __forceinline__ void init(int M, int N, int G_, int c_, const bf16* Bt_) { nM = M / BM; nN = N / BM; G = G_; c = c_; Bt = Bt_; }
    __device__ __forceinline__ bool next(int i, Unit& u) const { u.e = i; return tile_order(i, G, c, nM, nN, u.pm, u.pn); }
    __device__ __forceinline__ unsigned arow(const Unit& u, int r) const { return (unsigned)(u.pm * BM + r) * (unsigned)(K * 2); }
    __device__ __forceinline__ const char* bptr(const Unit& u) const { return (const char*)Bt + (size_t)u.pn * BM * K * 2; }
};
struct DenseSplit8 {
    static constexpr int KB = K * 2;
    int nM, nN, G, c; const bf16* Bt;
    __device__ __forceinline__ void init(int M, int N, int G_, int c_, const bf16* Bt_) { nM = M / BM; nN = N / BM; G = G_; c = c_; Bt = Bt_; }
    __device__ __forceinline__ bool next(int i, Unit& u) const { const long L = (long)i * G + c; if (L >= (long)nM * nN * 8) return false; const int t = (int)(L >> 3); u.e = (int)(L & 7); u.pm = t / nN; u.pn = t % nN; return true; }
    __device__ __forceinline__ unsigned arow(const Unit& u, int r) const { return (unsigned)(u.pm * BM + r) * (unsigned)KB + (unsigned)u.e * 512u; }
    __device__ __forceinline__ const char* bptr(const Unit& u) const { return (const char*)Bt + (size_t)u.pn * BM * KB + (size_t)u.e * 512; }
};
template <bool GATHER> struct GroupedOrder {
    static constexpr int KB = K;
    int nM, nN, G, c; const void* Bt; const int* tok; const volatile LAS int* tpre;
    __device__ __forceinline__ bool next(int i, Unit& u) const {
        if (!tile_order(i, G, c, nM, nN, u.pm, u.pn)) return false;
        int e = 0;
        for (int j = 1; j < NE; ++j) e += (tpre[j] <= u.pm) ? 1 : 0;
        u.e = __builtin_amdgcn_readfirstlane(e); return true;
    }
    __device__ __forceinline__ unsigned arow(const Unit& u, int r) const {
        if (GATHER) return (unsigned)tok[u.pm * BM + r] * (unsigned)KB;
        return (unsigned)(u.pm * BM + r) * (unsigned)KB;
    }
    __device__ __forceinline__ const char* bptr(const Unit& u) const { return (const char*)Bt + ((size_t)u.e * nN + u.pn) * (size_t)BM * KB; }
};

__device__ __forceinline__ unsigned cvt_pk_bf16(float lo, float hi) { unsigned r; asm volatile("v_cvt_pk_bf16_f32 %0, %1, %2" : "=v"(r) : "v"(lo), "v"(hi)); return r; }

struct EpiInProj {
    static constexpr bool PERM = true, KSEG = false;
    bf16* O; float qscale; const float* rs;
    __device__ __forceinline__ void kseg(f32x4 (&)[2][2][4][2], const Unit&, int, int, int) const {}
    __device__ __forceinline__ void operator()(const f32x4 (&acc)[2][2][4][2], const Unit& u, int wr, int wc, int fr, int fq) const {
        const int row0 = u.pm * BM + wr * 64 + fr, col0 = u.pn * BM + wc * 32 + 8 * fq;
        const int mode = (u.pn >= 4 && u.pn < 12) ? 1 : (u.pn >= 12 ? 2 : 0);
        float rrv[2][4];
#pragma unroll
        for (int ai = 0; ai < 2; ++ai)
#pragma unroll
            for (int m = 0; m < 4; ++m) rrv[ai][m] = rs[row0 + ai * HALF + m * 16];
        asm volatile("" : "+v"(rrv[0][0]), "+v"(rrv[0][1]), "+v"(rrv[0][2]), "+v"(rrv[0][3]), "+v"(rrv[1][0]), "+v"(rrv[1][1]), "+v"(rrv[1][2]), "+v"(rrv[1][3]));
#pragma unroll
        for (int ai = 0; ai < 2; ++ai)
#pragma unroll
            for (int m = 0; m < 4; ++m) { bf16* rowp = O + (size_t)(row0 + ai * HALF + m * 16) * INC + col0; const float rr = (mode == 2) ? rrv[ai][m] * qscale : rrv[ai][m];
#pragma unroll
                for (int bj = 0; bj < 2; ++bj) { f32x4 v0 = acc[ai][bj][m][0] * rr, v1 = acc[ai][bj][m][1] * rr;
                    if (mode == 1) {
#pragma unroll
                        for (int j = 0; j < 4; ++j) { v0[j] = gelu_tanh(v0[j]); v1[j] = gelu_tanh(v1[j]); } }
                    v4u w; w.x = cvt_pk_bf16(v0[0], v0[1]); w.y = cvt_pk_bf16(v0[2], v0[3]); w.z = cvt_pk_bf16(v1[0], v1[1]); w.w = cvt_pk_bf16(v1[2], v1[3]);
                    *(v4u*)(rowp + bj * HALF) = w; } }
    }
};
struct EpiPlainBf16 {
    static constexpr bool PERM = true, KSEG = false;
    bf16* O; int ldc;
    __device__ __forceinline__ void kseg(f32x4 (&)[2][2][4][2], const Unit&, int, int, int) const {}
    __device__ __forceinline__ void operator()(const f32x4 (&acc)[2][2][4][2], const Unit& u, int wr, int wc, int fr, int fq) const {
        const int row0 = u.pm * BM + wr * 64 + fr, col0 = u.pn * BM + wc * 32 + 8 * fq;
#pragma unroll
        for (int ai = 0; ai < 2; ++ai)
#pragma unroll
            for (int m = 0; m < 4; ++m) { bf16* rowp = O + (size_t)(row0 + ai * HALF + m * 16) * ldc + col0;
#pragma unroll
                for (int bj = 0; bj < 2; ++bj) { const f32x4 v0 = acc[ai][bj][m][0], v1 = acc[ai][bj][m][1];
                    v4u w; w.x = cvt_pk_bf16(v0[0], v0[1]); w.y = cvt_pk_bf16(v0[2], v0[3]); w.z = cvt_pk_bf16(v1[0], v1[1]); w.w = cvt_pk_bf16(v1[2], v1[3]);
                    *(v4u*)(rowp + bj * HALF) = w; } }
    }
};
struct EpiPartialF32 {
    static constexpr bool PERM = false, KSEG = false;
    bf16* O; int ldc; size_t slice_stride;
    __device__ __forceinline__ void kseg(f32x4 (&)[2][2][4][2], const Unit&, int, int, int) const {}
    __device__ __forceinline__ void operator()(const f32x4 (&acc)[2][2][4][2], const Unit& u, int wr, int wc, int fr, int fq) const {
        const int row0 = u.pm * BM + wr * 64 + fr, col0 = u.pn * BM + wc * 32 + 4 * fq; bf16* base = O + (size_t)u.e * slice_stride;
#pragma unroll
        for (int ai = 0; ai < 2; ++ai)
#pragma unroll
            for (int m = 0; m < 4; ++m) { bf16* rowp = base + (size_t)(row0 + ai * HALF + m * 16) * ldc + col0;
#pragma unroll
                for (int bj = 0; bj < 2; ++bj)
#pragma unroll
                    for (int n = 0; n < 2; ++n) { const f32x4 a = acc[ai][bj][m][n]; v2u w; w.x = cvt_pk_bf16(a[0], a[1]); w.y = cvt_pk_bf16(a[2], a[3]); *(v2u*)(rowp + bj * HALF + n * 16) = w; } }
    }
};
struct EpiOutProj {
    static constexpr bool PERM = true, KSEG = true;
    const bf16* X; bf16* Hout; const unsigned long long* ss;
    const LAS float* fac;
    __device__ __forceinline__ void kseg(f32x4 (&acc)[2][2][4][2], const Unit& u, int t, int wr, int fr) const {
#pragma unroll
        for (int ai = 0; ai < 2; ++ai)
#pragma unroll
            for (int m = 0; m < 4; ++m) {
                const float s = fac[(u.e * BM + wr * 64 + fr + ai * HALF + m * 16) * 3 + (t == 16 ? 0 : 1)];
#pragma unroll
                for (int bj = 0; bj < 2; ++bj)
#pragma unroll
                    for (int n = 0; n < 2; ++n) acc[ai][bj][m][n] = acc[ai][bj][m][n] * s; }
    }
    __device__ __forceinline__ void operator()(const f32x4 (&acc)[2][2][4][2], const Unit& u, int wr, int wc, int fr, int fq) const {
        const int row0 = u.pm * BM + wr * 64 + fr, col0 = u.pn * BM + wc * 32 + 8 * fq;
#pragma unroll
        for (int ai = 0; ai < 2; ++ai)
#pragma unroll
          for (int mp = 0; mp < 2; ++mp) {
            v4u xv[2][2];
#pragma unroll
            for (int mm = 0; mm < 2; ++mm)
#pragma unroll
                for (int bj = 0; bj < 2; ++bj) xv[mm][bj] = *(const v4u*)(X + (size_t)(row0 + ai * HALF + (2 * mp + mm) * 16) * D + col0 + bj * HALF);
#pragma unroll
            for (int mm = 0; mm < 2; ++mm) asm volatile("" : "+v"(xv[mm][0]), "+v"(xv[mm][1]));
#pragma unroll
            for (int mm = 0; mm < 2; ++mm) { const int m = 2 * mp + mm; const int r = row0 + ai * HALF + m * 16; const size_t off = (size_t)r * D + col0;
                const float s = fac[(u.e * BM + wr * 64 + fr + ai * HALF + m * 16) * 3 + 2];
#pragma unroll
                for (int bj = 0; bj < 2; ++bj) { const v4u xq = xv[mm][bj];
                    const f32x4 h0 = (f32x4){bflo(xq.x), bfhi(xq.x), bflo(xq.y), bfhi(xq.y)} + acc[ai][bj][m][0] * s, h1 = (f32x4){bflo(xq.z), bfhi(xq.z), bflo(xq.w), bfhi(xq.w)} + acc[ai][bj][m][1] * s;
                    v4u w; w.x = cvt_pk_bf16(h0[0], h0[1]); w.y = cvt_pk_bf16(h0[2], h0[3]); w.z = cvt_pk_bf16(h1[0], h1[1]); w.w = cvt_pk_bf16(h1[2], h1[3]);
                    *(v4u*)(Hout + off + bj * HALF) = w; } } }
    }
};
struct EpiGateUp {
    static constexpr bool PERM = true, KSEG = false;
    unsigned char* O; const float* bias; const float* rs; LAS unsigned char* stg;
    static constexpr int SST = 144;
    __device__ __forceinline__ void kseg(f32x4 (&)[2][2][4][2], const Unit&, int, int, int) const {}
    __device__ __forceinline__ void operator()(const f32x4 (&acc)[2][2][4][2], const Unit& u, int wr, int wc, int fr, int fq) const {
        const int row0 = u.pm * BM + wr * 64 + fr, col0 = u.pn * BM + wc * 32 + 8 * fq;
        const float* bp = bias + (size_t)u.e * 4096 + col0;
        f32x4 bv[2][2];
#pragma unroll
        for (int bj = 0; bj < 2; ++bj)
#pragma unroll
            for (int n = 0; n < 2; ++n) bv[bj][n] = *(const f32x4*)(bp + bj * HALF + 4 * n);
        float rrv[2][4];
#pragma unroll
        for (int ai = 0; ai < 2; ++ai)
#pragma unroll
            for (int m = 0; m < 4; ++m) rrv[ai][m] = rs[row0 + ai * HALF + m * 16];
        asm volatile("" : "+v"(rrv[0][0]), "+v"(rrv[0][1]), "+v"(rrv[0][2]), "+v"(rrv[0][3]), "+v"(rrv[1][0]), "+v"(rrv[1][1]), "+v"(rrv[1][2]), "+v"(rrv[1][3]));
        const int tid = (wr * 4 + wc) * 64 + fq * 16 + fr;
#pragma unroll
        for (int ai = 0; ai < 2; ++ai) {
#pragma unroll
            for (int m = 0; m < 4; ++m) { const float rr = rrv[ai][m]; LAS unsigned char* rowp = stg + (wr * 64 + m * 16 + fr) * SST + wc * 16 + 4 * fq;
#pragma unroll
                for (int bj = 0; bj < 2; ++bj) { const f32x4 v0 = acc[ai][bj][m][0] * rr + bv[bj][0], v1 = acc[ai][bj][m][1] * rr + bv[bj][1];
                    float a[4];
                    const float gg[4] = {v0[0], v0[2], v1[0], v1[2]}, uu[4] = {v0[1], v0[3], v1[1], v1[3]};
#pragma unroll
                    for (int j = 0; j < 4; ++j) { const float g = fminf(gg[j], 7.0f), up = fminf(fmaxf(uu[j], -7.0f), 7.0f);
                        const float glu = g * fast_rcp(1.0f + fast_exp2(-1.702f * 1.4426950409f * g)); a[j] = __builtin_fmaf(up, glu, glu); }
                    int pw = __builtin_amdgcn_cvt_pk_fp8_f32(a[0], a[1], 0, false); pw = __builtin_amdgcn_cvt_pk_fp8_f32(a[2], a[3], pw, true);
                    *(LAS unsigned*)(rowp + bj * (HALF / 2)) = (unsigned)pw; } }
            asm volatile("s_waitcnt lgkmcnt(0)" ::: "memory"); __builtin_amdgcn_s_barrier(); asm volatile("" ::: "memory");
#pragma unroll
            for (int p = 0; p < 2; ++p) { const int idx = tid + 512 * p, row = idx >> 3, ch = idx & 7;
                const v4u d = *(const LAS v4u*)(stg + row * SST + 16 * ch);
                *(v4u*)(O + (size_t)(u.pm * BM + ai * HALF + row) * 2048 + u.pn * 128 + 16 * ch) = d; }
            if (ai == 0) { asm volatile("s_waitcnt lgkmcnt(0)" ::: "memory"); __builtin_amdgcn_s_barrier(); asm volatile("" ::: "memory"); }
        }
    }
};
struct EpiDown {
    static constexpr bool PERM = true, KSEG = false;
    unsigned char* O; const float* bias; const float* gate; LAS unsigned char* stg;
    static constexpr int SST = 144;
    __device__ __forceinline__ void kseg(f32x4 (&)[2][2][4][2], const Unit&, int, int, int) const {}
    __device__ __forceinline__ void operator()(const f32x4 (&acc)[2][2][4][2], const Unit& u, int wr, int wc, int fr, int fq) const {
        const int row0 = u.pm * BM + wr * 64 + fr, col0 = u.pn * BM + wc * 32 + 8 * fq;
        const float* bp = bias + (size_t)u.e * 2048 + col0;
        f32x4 bv[2][2];
#pragma unroll
        for (int bj = 0; bj < 2; ++bj)
#pragma unroll
            for (int n = 0; n < 2; ++n) bv[bj][n] = *(const f32x4*)(bp + bj * HALF + 4 * n);
        float gtv[2][4];
#pragma unroll
        for (int ai = 0; ai < 2; ++ai)
#pragma unroll
            for (int m = 0; m < 4; ++m) gtv[ai][m] = gate[row0 + ai * HALF + m * 16];
        asm volatile("" : "+v"(gtv[0][0]), "+v"(gtv[0][1]), "+v"(gtv[0][2]), "+v"(gtv[0][3]), "+v"(gtv[1][0]), "+v"(gtv[1][1]), "+v"(gtv[1][2]), "+v"(gtv[1][3]));
        const int tid = (wr * 4 + wc) * 64 + fq * 16 + fr;
#pragma unroll
        for (int ai = 0; ai < 2; ++ai)
#pragma unroll
            for (int bj = 0; bj < 2; ++bj) {
#pragma unroll
                for (int m = 0; m < 4; ++m) { const float gt = gtv[ai][m] * 16.0f;
                    const f32x4 v0 = (acc[ai][bj][m][0] + bv[bj][0]) * gt, v1 = (acc[ai][bj][m][1] + bv[bj][1]) * gt;
                    v2u w; w.x = pk4_fp8_sc(v0[0], v0[1], v0[2], v0[3]); w.y = pk4_fp8_sc(v1[0], v1[1], v1[2], v1[3]);
                    *(LAS v2u*)(stg + (wr * 64 + m * 16 + fr) * SST + wc * 32 + 8 * fq) = w; }
                asm volatile("s_waitcnt lgkmcnt(0)" ::: "memory"); __builtin_amdgcn_s_barrier(); asm volatile("" ::: "memory");
#pragma unroll
                for (int p = 0; p < 2; ++p) { const int idx = tid + 512 * p, row = idx >> 3, ch = idx & 7;
                    const v4u d = *(const LAS v4u*)(stg + row * SST + 16 * ch);
                    *(v4u*)(O + (size_t)(u.pm * BM + ai * HALF + row) * 2048 + u.pn * BM + bj * HALF + 16 * ch) = d; }
                if (ai == 0 || bj == 0) { asm volatile("s_waitcnt lgkmcnt(0)" ::: "memory"); __builtin_amdgcn_s_barrier(); asm volatile("" ::: "memory"); }
            }
    }
};

template <int FMT, int KDIV = 1, class Epi, class Sched>
__device__ __forceinline__ void gemm_phase(LAS unsigned char* lds, const void* Abase, const Sched& S, const Epi& E, int wave) {
    constexpr bool FP8 = FMT != 0;
    constexpr int KB = Sched::KB, NT = (FP8 ? K / 128 : K / 64) / KDIV;
    const int wid = wave, lane = lane_id(), tid = wid * 64 + lane, wr = wid >> 2, wc = wid & 3, fr = lane & 15, fq = lane >> 4;
    int Rr[2]; unsigned cofs[2], voffB[2];
#pragma unroll
    for (int i = 0; i < 2; ++i) { int R, C; stage_rc(tid * 16 + i * 8192, R, C); const int Rb = Epi::PERM ? ((R & ~31) + perm32(R & 31)) : R;
        Rr[i] = R; cofs[i] = (unsigned)C * 2u; voffB[i] = (unsigned)(Rb * KB + C * 2); }
    const size_t kstep = (size_t)(BK * 2);
    const size_t hstep = (size_t)HALF * KB;
    const unsigned ldsw = (unsigned)wid * 1024u;
    const int aoff = lds_byte(wr * 64 + fr, fq * 8), boff = lds_byte(wc * 32 + fr, fq * 8);
#define PG8_SA(b, h) (((b) * 2 + (h)) * HTB)
#define PG8_SB(b, h) ((4 + (b) * 2 + (h)) * HTB)
#define PG8_STAGE(bufoff, gbase, voff) do { _Pragma("unroll") for (int _i = 0; _i < 2; ++_i) \
        __builtin_amdgcn_global_load_lds((const unsigned*)((const char*)(gbase) + (voff)[_i]), (LAS unsigned*)(lds + (bufoff) + ldsw + _i * 8192), 16, 0, 0); } while (0)
#define PG8_STAGE2(bufoff, gbase, o0, o1) do { \
        __builtin_amdgcn_global_load_lds((const unsigned*)((const char*)(gbase) + (o0)), (LAS unsigned*)(lds + (bufoff) + ldsw), 16, 0, 0); \
        __builtin_amdgcn_global_load_lds((const unsigned*)((const char*)(gbase) + (o1)), (LAS unsigned*)(lds + (bufoff) + ldsw + 8192), 16, 0, 0); } while (0)
#define PG8_LDA(dst, b, h) do { _Pragma("unroll") for (int m = 0; m < 4; ++m) { \
        if constexpr (FP8) { dst##8[m].lo = *(const LAS i32x4*)(lds + PG8_SA(b, h) + aoff + m * 2048); dst##8[m].hi = *(const LAS i32x4*)(lds + PG8_SA(b, h) + aoff + m * 2048 + 1024); } \
        else { _Pragma("unroll") for (int k = 0; k < 2; ++k) dst[m][k] = *(const LAS bf16x8*)(lds + PG8_SA(b, h) + aoff + m * 2048 + k * 1024); } } } while (0)
#define PG8_LDB(dst, b, h) do { _Pragma("unroll") for (int n = 0; n < 2; ++n) { \
        if constexpr (FP8) { dst##8[n].lo = *(const LAS i32x4*)(lds + PG8_SB(b, h) + boff + n * 2048); dst##8[n].hi = *(const LAS i32x4*)(lds + PG8_SB(b, h) + boff + n * 2048 + 1024); } \
        else { _Pragma("unroll") for (int k = 0; k < 2; ++k) dst[n][k] = *(const LAS bf16x8*)(lds + PG8_SB(b, h) + boff + n * 2048 + k * 1024); } } } while (0)
#define PG8_MMA(ai, bj, At, Bt) do { __builtin_amdgcn_s_setprio(1); _Pragma("unroll") for (int m = 0; m < 4; ++m) _Pragma("unroll") for (int n = 0; n < 2; ++n) { \
        if constexpr (FMT == 2) { asm volatile("s_nop 1\n\tv_mfma_scale_f32_16x16x128_f8f6f4 %0, %1, %2, %0, %3, %4 op_sel_hi:[0,0,0] cbsz:2 blgp:2"     : "+v"(acc[ai][bj][m][n]) : "v"(__builtin_shufflevector(Bt##8[n], Bt##8[n], 0, 1, 2, 3, 4, 5)), "v"(__builtin_shufflevector(At##8[m], At##8[m], 0, 1, 2, 3, 4, 5)), "v"(Bt##8[n][6]), "v"(At##8[m][6])); } else \
        if constexpr (FP8) { asm volatile("v_mfma_scale_f32_16x16x128_f8f6f4 %0, %1, %2, %0, %3, %4 op_sel_hi:[0,0,0]" : "+v"(acc[ai][bj][m][n]) : "v"(Bt##8[n]), "v"(At##8[m]), "v"(sclW), "v"(sclA)); } \
        else { _Pragma("unroll") for (int k = 0; k < 2; ++k) acc[ai][bj][m][n] = __builtin_amdgcn_mfma_f32_16x16x32_bf16(Bt[n][k], At[m][k], acc[ai][bj][m][n], 0, 0, 0); } } \
        __builtin_amdgcn_s_setprio(0); } while (0)
#define PG8_WAIT_V(n) asm volatile("s_waitcnt vmcnt(" #n ")" ::: "memory")
#define PG8_WAIT_L(n) asm volatile("s_waitcnt lgkmcnt(" #n ")" ::: "memory")
#define PG8_BAR __builtin_amdgcn_s_barrier()
#define PG8_SCHED __builtin_amdgcn_sched_barrier(0)
    Unit cur, nxt; int ui = 0;
    if (!S.next(0, cur)) return;
    f32x4 acc[2][2][4][2];
#pragma unroll
    for (int a = 0; a < 2; ++a)
#pragma unroll
        for (int b = 0; b < 2; ++b)
#pragma unroll
            for (int m = 0; m < 4; ++m)
#pragma unroll
                for (int n = 0; n < 2; ++n) acc[a][b][m][n] = (f32x4){0.f, 0.f, 0.f, 0.f};
    bf16x8 At[4][2], B0[2][2], B1[2][2]; i32x8 At8[4], B08[2], B18[2];
    const int sclW = 0x77777777, sclA = 0x7f7f7f7f;
    unsigned vA00 = S.arow(cur, Rr[0]) + cofs[0], vA01 = S.arow(cur, Rr[1]) + cofs[1], vA10 = S.arow(cur, HALF + Rr[0]) + cofs[0], vA11 = S.arow(cur, HALF + Rr[1]) + cofs[1];
    bool has_next = S.next(1, nxt);
    unsigned nA00 = vA00, nA01 = vA01, nA10 = vA10, nA11 = vA11;
    if (has_next) { nA00 = S.arow(nxt, Rr[0]) + cofs[0]; nA01 = S.arow(nxt, Rr[1]) + cofs[1]; nA10 = S.arow(nxt, HALF + Rr[0]) + cofs[0]; nA11 = S.arow(nxt, HALF + Rr[1]) + cofs[1]; }
    asm volatile("" : "+v"(vA00), "+v"(vA01), "+v"(vA10), "+v"(vA11), "+v"(nA00), "+v"(nA01), "+v"(nA10), "+v"(nA11));
    const char* gA = (const char*)Abase;
    const char* cB = S.bptr(cur); const char* nB = has_next ? S.bptr(nxt) : cB;
    PG8_STAGE(PG8_SB(0, 0), cB, voffB); PG8_STAGE(PG8_SB(0, 1), cB + hstep, voffB); PG8_STAGE2(PG8_SA(0, 0), gA, vA00, vA01); PG8_STAGE2(PG8_SA(0, 1), gA, vA10, vA11);
    if (wr == 1) PG8_BAR;
    PG8_WAIT_V(2); PG8_BAR;
    PG8_STAGE(PG8_SB(1, 0), cB + kstep, voffB); PG8_STAGE2(PG8_SA(1, 0), gA + kstep, vA00, vA01); PG8_STAGE(PG8_SB(1, 1), cB + hstep + kstep, voffB);
    PG8_WAIT_V(6); PG8_BAR;
    for (;;) {
#pragma unroll 1
        for (int t = 0; t < NT; t += 2) {
            const bool last = (t == NT - 2);
            if constexpr (Epi::KSEG && !FP8) { if (t == 16 || t == 24) E.kseg(acc, cur, t, wr, fr); }
            const char* a1 = gA + (size_t)(t + 1) * kstep;
            const char* a2 = last ? gA : gA + (size_t)(t + 2) * kstep; const char* b2 = last ? nB : cB + (size_t)(t + 2) * kstep;
            const char* a3 = a2 + kstep; const char* b3 = b2 + kstep;
            const unsigned s00 = last ? nA00 : vA00, s01 = last ? nA01 : vA01, s10 = last ? nA10 : vA10, s11 = last ? nA11 : vA11;
            PG8_LDB(B0, 0, 0); PG8_LDB(B1, 0, 1); PG8_SCHED; PG8_LDA(At, 0, 0); PG8_STAGE2(PG8_SA(1, 1), a1, vA10, vA11);
            PG8_WAIT_V(8); PG8_WAIT_L(0); PG8_BAR; PG8_MMA(0, 0, At, B0); PG8_MMA(0, 1, At, B1); PG8_BAR; PG8_SCHED;
            PG8_LDA(At, 0, 1); PG8_STAGE(PG8_SB(0, 0), b2, voffB); PG8_STAGE(PG8_SB(0, 1), b2 + hstep, voffB); PG8_STAGE2(PG8_SA(0, 0), a2, s00, s01);
            PG8_WAIT_V(8); PG8_WAIT_L(0); PG8_BAR; PG8_MMA(1, 0, At, B0); PG8_MMA(1, 1, At, B1); PG8_BAR; PG8_SCHED;
            PG8_LDB(B0, 1, 0); PG8_LDB(B1, 1, 1); PG8_SCHED; PG8_LDA(At, 1, 0); PG8_STAGE2(PG8_SA(0, 1), a2, s10, s11);
            PG8_WAIT_V(8); PG8_WAIT_L(0); PG8_BAR; PG8_MMA(0, 0, At, B0); PG8_MMA(0, 1, At, B1); PG8_BAR; PG8_SCHED;
            PG8_LDA(At, 1, 1); PG8_STAGE(PG8_SB(1, 0), b3, voffB); PG8_STAGE(PG8_SB(1, 1), b3 + hstep, voffB); PG8_STAGE2(PG8_SA(1, 0), a3, s00, s01);
            PG8_WAIT_V(8); PG8_WAIT_L(0); PG8_BAR; PG8_MMA(1, 0, At, B0); PG8_MMA(1, 1, At, B1); PG8_BAR; PG8_SCHED;
        }
        Unit nn; const bool nn_has = has_next ? S.next(ui + 2, nn) : false;
        unsigned t00 = nA00, t01 = nA01, t10 = nA10, t11 = nA11;
        if (nn_has) { t00 = S.arow(nn, Rr[0]) + cofs[0]; t01 = S.arow(nn, Rr[1]) + cofs[1]; t10 = S.arow(nn, HALF + Rr[0]) + cofs[0]; t11 = S.arow(nn, HALF + Rr[1]) + cofs[1]; }
        asm volatile("" : "+v"(t00), "+v"(t01), "+v"(t10), "+v"(t11));
        if constexpr (FP8) { asm volatile("s_nop 15\n\ts_nop 15" ::: "memory"); PG8_SCHED; }
        if (wr == 0) PG8_BAR;
        E(acc, cur, wr, wc, fr, fq);
        if (!has_next) break;
#pragma unroll
        for (int a = 0; a < 2; ++a)
#pragma unroll
            for (int b = 0; b < 2; ++b)
#pragma unroll
                for (int m = 0; m < 4; ++m)
#pragma unroll
                    for (int n = 0; n < 2; ++n) acc[a][b][m][n] = (f32x4){0.f, 0.f, 0.f, 0.f};
        cur = nxt; cB = nB; vA00 = nA00; vA01 = nA01; vA10 = nA10; vA11 = nA11; ++ui;
        has_next = nn_has; nxt = nn; nA00 = t00; nA01 = t01; nA10 = t10; nA11 = t11;
        nB = has_next ? S.bptr(nxt) : cB;
        if (wr == 1) PG8_BAR;
    }
    PG8_WAIT_V(0);
    PG8_BAR;
#undef PG8_SA
#undef PG8_SB
#undef PG8_STAGE
#undef PG8_STAGE2
#undef PG8_LDA
#undef PG8_LDB
#undef PG8_MMA
#undef PG8_WAIT_V
#undef PG8_WAIT_L
#undef PG8_BAR
#undef PG8_SCHED
}
}

struct Frame {
    LAS unsigned char* lds;
    volatile LAS unsigned* LC;
    int tid, lane, wave, G, bx, rep;
    unsigned char* ws;
};
enum { I_X = 0, I_MEM, I_LNMIX, I_WIN, I_CONVW, I_CONVB, I_WRGA, I_BRGA, I_WRGI, I_BRGI, I_LAM, I_GMVG, I_WSP, I_BSP, I_MEMG, I_WMK, I_WMV,
       I_OUTG, I_WOUT, I_LNFFN, I_WR, I_BR, I_WGU, I_BGU, I_WD, I_BD, I_FING };

__device__ __forceinline__ const float* inp(const Frame& F, int i) {
    const LAS unsigned* p = (const LAS unsigned*)(F.lds + LDSCTL_OFF) + LC_PTR + 2 * i;
    const unsigned lo = __builtin_amdgcn_readfirstlane(p[0]), hi = __builtin_amdgcn_readfirstlane(p[1]);
    return (const float*)(((unsigned long long)hi << 32) | lo);
}
__device__ __forceinline__ void p0_tr_item(const float* W, int N, bf16* WT, int Kd, const float* kscale, LAS float* scr, int kb, int nb, int lane) {
    const int k0 = kb * 64, n0 = nb * 64, lr = lane >> 4, lc = lane & 15;
    f32x4 v[16];
#pragma unroll
    for (int i = 0; i < 16; ++i) v[i] = *(const GAS f32x4*)(W + (size_t)(k0 + 4 * i + lr) * N + n0 + 4 * lc);
    if (kscale) {
#pragma unroll
        for (int i = 0; i < 16; ++i) { const float s = kscale[k0 + 4 * i + lr]; v[i] = v[i] * s; } }
#pragma unroll
    for (int i = 0; i < 16; ++i) { LAS float* d = scr + (4 * i + lr) * 65 + 4 * lc; d[0] = v[i][0]; d[1] = v[i][1]; d[2] = v[i][2]; d[3] = v[i][3]; }
    LDS_WAIT();
    const int c = lane & 7;
#pragma unroll
    for (int j = 0; j < 8; ++j) { const int n = (lane >> 3) + 8 * j; const LAS float* s = scr + (8 * c) * 65 + n;
        v4u o; o.x = pk2(s[0 * 65], s[1 * 65]); o.y = pk2(s[2 * 65], s[3 * 65]); o.z = pk2(s[4 * 65], s[5 * 65]); o.w = pk2(s[6 * 65], s[7 * 65]);
        *(GAS v4u*)(WT + (size_t)(n0 + n) * Kd + k0 + 8 * c) = o; }
    LDS_WAIT();
}
struct TrItem { const float* W; unsigned char* WT; const float* ks; int N, kb, nb, f6; };
__device__ __forceinline__ TrItem p0_decode_fp8(const float* wgu, const float* wd, unsigned char* WguT, unsigned char* WdT, const float* g, int r) {
    TrItem t;
    if (r < 65536) { const int e = r >> 11, q = r & 2047; t.W = wgu + (size_t)e * 2048 * 4096; t.WT = WguT + (size_t)e * 4096 * 2048; t.ks = g; t.N = 4096; t.kb = q >> 7; t.nb = q & 127; t.f6 = 1; }
    else { r -= 65536; const int e = r >> 10, q = r & 1023; t.W = wd + (size_t)e * 2048 * 2048; t.WT = WdT + (size_t)e * 2048 * 2048; t.ks = nullptr; t.N = 2048; t.kb = q >> 6; t.nb = q & 63; t.f6 = 0; }
    return t;
}
__device__ __forceinline__ void p0_tr_load(const TrItem& t, f32x4 (&v)[16], int lane) {
    const int k0 = t.kb * 128, n0 = t.nb * 32, lr = lane >> 3, lc = lane & 7;
#pragma unroll
    for (int i = 0; i < 16; ++i) v[i] = __builtin_nontemporal_load((const GAS f32x4*)(t.W + (size_t)(k0 + 16 * lr + i) * t.N + n0 + 4 * lc));
}
__device__ __forceinline__ void p0_tr_finish_fp6(const TrItem& t, const f32x4 (&v)[16], LAS float* scr, int lane) {
    const int k0 = t.kb * 128, n0 = t.nb * 32, lr = lane >> 3, lc = lane & 7;
#pragma unroll
    for (int i = 0; i < 16; ++i) { const float sc = t.ks ? t.ks[k0 + 16 * lr + i] : 1.0f; LAS float* d = scr + (16 * lr + i) * 33 + 4 * lc; d[0] = v[i][0] * sc; d[1] = v[i][1] * sc; d[2] = v[i][2] * sc; d[3] = v[i][3] * sc; }
    LDS_WAIT();
    const int n = lane & 31, hf = lane >> 5;
    v4u lo[2], hi[2];
#pragma unroll
    for (int bb = 0; bb < 2; ++bb) { float x[32];
#pragma unroll
        for (int e = 0; e < 32; ++e) x[e] = scr[(32 * (2 * hf + bb) + e) * 33 + n];
        pack_fp6(x, lo[bb], hi[bb]); }
    LDS_WAIT();
    LAS unsigned char* ob = (LAS unsigned char*)scr;
#pragma unroll
    for (int bb = 0; bb < 2; ++bb) { *(LAS v4u*)(ob + n * 128 + 16 * (2 * hf + bb)) = lo[bb]; *(LAS v4u*)(ob + n * 128 + 64 + 16 * (2 * hf + bb)) = hi[bb]; }
    LDS_WAIT();
#pragma unroll
    for (int p = 0; p < 4; ++p) { const int idx = p * 64 + lane, row = idx >> 3, ch = idx & 7;
        __builtin_nontemporal_store(*(const LAS v4u*)(ob + row * 128 + 16 * ch), (GAS v4u*)(t.WT + (size_t)(n0 + row) * 2048 + k0 + 16 * ch)); }
    LDS_WAIT();
}
__device__ __forceinline__ void p0_tr_finish_fp8(const TrItem& t, const f32x4 (&v)[16], LAS float* scr, int lane) {
    const int k0 = t.kb * 128, n0 = t.nb * 32, lr = lane >> 3, lc = lane & 7;
#pragma unroll
    for (int i = 0; i < 16; ++i) { LAS float* d = scr + (16 * lr + i) * 33 + 4 * lc; d[0] = v[i][0] * 256.f; d[1] = v[i][1] * 256.f; d[2] = v[i][2] * 256.f; d[3] = v[i][3] * 256.f; }
    LDS_WAIT();
    const int n = lane & 31, hf = lane >> 5;
    v4u o[2][2];
#pragma unroll
    for (int bb = 0; bb < 2; ++bb) { float x[32];
#pragma unroll
        for (int e = 0; e < 32; ++e) x[e] = scr[(32 * (2 * hf + bb) + e) * 33 + n];
#pragma unroll
        for (int q = 0; q < 2; ++q) { o[bb][q].x = pk4_fp8_sc(x[16 * q], x[16 * q + 1], x[16 * q + 2], x[16 * q + 3]); o[bb][q].y = pk4_fp8_sc(x[16 * q + 4], x[16 * q + 5], x[16 * q + 6], x[16 * q + 7]);
            o[bb][q].z = pk4_fp8_sc(x[16 * q + 8], x[16 * q + 9], x[16 * q + 10], x[16 * q + 11]); o[bb][q].w = pk4_fp8_sc(x[16 * q + 12], x[16 * q + 13], x[16 * q + 14], x[16 * q + 15]); } }
    LDS_WAIT();
    LAS unsigned char* ob = (LAS unsigned char*)scr;
#pragma unroll
    for (int bb = 0; bb < 2; ++bb) { *(LAS v4u*)(ob + n * 128 + 32 * (2 * hf + bb)) = o[bb][0]; *(LAS v4u*)(ob + n * 128 + 32 * (2 * hf + bb) + 16) = o[bb][1]; }
    LDS_WAIT();
#pragma unroll
    for (int p = 0; p < 4; ++p) { const int idx = p * 64 + lane, row = idx >> 3, ch = idx & 7;
        __builtin_nontemporal_store(*(const LAS v4u*)(ob + row * 128 + 16 * ch), (GAS v4u*)(t.WT + (size_t)(n0 + row) * 2048 + k0 + 16 * ch)); }
    LDS_WAIT();
}
__device__ __forceinline__ void norm_row_bf16(const float* xrow, const float* g, bf16* orow, int lane) {
    const GAS f32x4* xr = (const GAS f32x4*)xrow + lane;
    f32x4 v[8]; float s = 0.f;
#pragma unroll
    for (int j = 0; j < 8; ++j) { v[j] = __builtin_nontemporal_load(xr + 64 * j); s += (v[j][0] * v[j][0] + v[j][1] * v[j][1]) + (v[j][2] * v[j][2] + v[j][3] * v[j][3]); }
    const float r = 1.0f / __builtin_sqrtf(wave_sum(s) * (1.0f / D) + EPS);
    GAS v2u* o8 = (GAS v2u*)orow + lane;
#pragma unroll
    for (int j = 0; j < 8; ++j) { const f32x4 gg = ((const GAS f32x4*)g)[lane + 64 * j];
        v2u o; o.x = pk2(v[j][0] * r * gg[0], v[j][1] * r * gg[1]); o.y = pk2(v[j][2] * r * gg[2], v[j][3] * r * gg[3]); o8[64 * j] = o; }
}
__device__ __forceinline__ void raw_row_bf16(const float* xrow, bf16* orow, float* rstd_out, int lane) {
    const GAS f32x4* xr = (const GAS f32x4*)xrow + lane;
    f32x4 v[8]; float s = 0.f;
#pragma unroll
    for (int j = 0; j < 8; ++j) { v[j] = __builtin_nontemporal_load(xr + 64 * j); s += (v[j][0] * v[j][0] + v[j][1] * v[j][1]) + (v[j][2] * v[j][2] + v[j][3] * v[j][3]); }
    GAS v2u* o8 = (GAS v2u*)orow + lane;
#pragma unroll
    for (int j = 0; j < 8; ++j) { v2u o; o.x = pk2(v[j][0], v[j][1]); o.y = pk2(v[j][2], v[j][3]); o8[64 * j] = o; }
    const float r = 1.0f / __builtin_sqrtf(wave_sum(s) * (1.0f / D) + EPS);
    if (lane == 0) *rstd_out = r;
}
__device__ __forceinline__ void p0_prologue(Frame& F) {
    LAS float* scr = (LAS float*)(F.lds + F.wave * 16896);
    const int gw = F.bx * 8 + F.wave, NGW = F.G * 8;
    bf16* WinT = (bf16*)(F.ws + WS_WIN); bf16* WoutT = (bf16*)(F.ws + WS_WOUT); bf16* WkT = (bf16*)(F.ws + WS_WKT); bf16* WvT = (bf16*)(F.ws + WS_WVT);
    bf16* WaT = (bf16*)(F.ws + WS_WA); bf16* WiT = (bf16*)(F.ws + WS_WI); unsigned char* WguT = F.ws + WS_WGU; unsigned char* WdT = F.ws + WS_WD;
    constexpr int I_IN = 32 * 56, I_OUT = 32 * 32, I_KV = 32 * 8, I_RG = 2 * 2 * 8, I_GU = 32 * 32 * 64, I_DN = 32 * 32 * 32;
    constexpr int NITEMS = I_IN + I_OUT + 2 * I_KV + 2 * I_RG;
    { const float* wgu = inp(F, I_WGU); const float* wd = inp(F, I_WD); const float* gf = inp(F, I_LNFFN);
      constexpr int NF = I_GU + I_DN;
      f32x4 va[16], vb[16]; TrItem ta, tb;
      int it = gw;
      if (it < NF) { ta = p0_decode_fp8(wgu, wd, WguT, WdT, gf, it); p0_tr_load(ta, va, F.lane); }
      for (; it < NF; it += 2 * NGW) {
          const bool hb = it + NGW < NF, ha = it + 2 * NGW < NF;
          if (hb) { tb = p0_decode_fp8(wgu, wd, WguT, WdT, gf, it + NGW); p0_tr_load(tb, vb, F.lane); }
          if (ta.f6) p0_tr_finish_fp6(ta, va, scr, F.lane); else p0_tr_finish_fp8(ta, va, scr, F.lane);
          if (ha) { ta = p0_decode_fp8(wgu, wd, WguT, WdT, gf, it + 2 * NGW); p0_tr_load(ta, va, F.lane); }
          if (hb) { if (tb.f6) p0_tr_finish_fp6(tb, vb, scr, F.lane); else p0_tr_finish_fp8(tb, vb, scr, F.lane); }
      } }
    for (int it = gw; it < NITEMS; it += NGW) {
        int r = it;
        if (r < I_IN) { p0_tr_item(inp(F, I_WIN), INC, WinT, 2048, inp(F, I_LNMIX), scr, r / 56, r % 56, F.lane); continue; } r -= I_IN;
        if (r < I_OUT) { p0_tr_item(inp(F, I_WOUT), 2048, WoutT, 2048, inp(F, I_OUTG), scr, r >> 5, r & 31, F.lane); continue; } r -= I_OUT;
        if (r < I_KV) { p0_tr_item(inp(F, I_WMK), 512, WkT, 2048, nullptr, scr, r >> 3, r & 7, F.lane); continue; } r -= I_KV;
        if (r < I_KV) { p0_tr_item(inp(F, I_WMV), 512, WvT, 2048, nullptr, scr, r >> 3, r & 7, F.lane); continue; } r -= I_KV;
        if (r < I_RG) { const int h = r >> 2, q = r & 3; p0_tr_item(inp(F, I_WRGA) + h * 16384, 128, WaT + h * 16384, 128, nullptr, scr, q >> 1, q & 1, F.lane); continue; } r -= I_RG;
        { const int h = r >> 2, q = r & 3; p0_tr_item(inp(F, I_WRGI) + h * 16384, 128, WiT + h * 16384, 128, nullptr, scr, q >> 1, q & 1, F.lane); }
    }
    bf16* XB = (bf16*)(F.ws + WS_XB); bf16* MEMN = (bf16*)(F.ws + WS_MEMN);
    for (int m = gw; m < NTOK; m += NGW) raw_row_bf16(inp(F, I_X) + (size_t)m * D, XB + (size_t)m * D, (float*)(F.ws + WS_RSTD0) + m, F.lane);
    for (int m = gw; m < NB * MEM; m += NGW) norm_row_bf16(inp(F, I_MEM) + (size_t)m * D, inp(F, I_MEMG), MEMN + (size_t)m * D, F.lane);
    { v4u* gz = (v4u*)(F.ws + WS_GRAN); for (int i = F.bx * 512 + F.tid; i < (int)(4 * MiB / 16); i += F.G * 512) gz[i] = (v4u){0u, 0u, 0u, 0u}; }
    const int gt = F.bx * 512 + F.tid, NGT = F.G * 512;
    bf16* WSP = (bf16*)(F.ws + WS_WSP); float* WRP = (float*)(F.ws + WS_WRP);
    for (int i = gt; i < 4 * 128 * 128; i += NGT) { const int s = i & 127, t = (i >> 7) & 127; WSP[i] = (bf16)f2bf(s <= t ? inp(F, I_WSP)[i] : 0.f); }
    for (int i = gt; i < 2048 * 32; i += NGT) { const int k = i >> 5, e = i & 31; WRP[((k >> 2) * 32 + e) * 4 + (k & 3)] = inp(F, I_LNFFN)[k] * inp(F, I_WR)[i]; }
}

__device__ __forceinline__ void xattn_unit(Frame& F, int b, int h, int part) {
    constexpr int KST = 272, VST = 528, VOFF = 256 * KST;
    const bf16* KB = (const bf16*)(F.ws + WS_KB); const bf16* VT = (const bf16*)(F.ws + WS_VT);
    const bf16* P = (const bf16*)(F.ws + WS_P); bf16* YB = (bf16*)(F.ws + WS_YBUF); unsigned long long* ssx = (unsigned long long*)(F.ws + (F.rep ? WS_DUMMY : CTL_SS)) + 2 * NTOK;
#pragma unroll
    for (int p = 0; p < 8; ++p) { const int idx = F.tid + 512 * p, row = idx >> 4, c16 = idx & 15;
        const v4u kv = *(const GAS v4u*)(KB + (size_t)(b * MEM + row) * 512 + h * HD + c16 * 8); *(LAS v4u*)(F.lds + row * KST + c16 * 16) = kv; }
#pragma unroll
    for (int p = 0; p < 8; ++p) { const int idx = F.tid + 512 * p, row = idx >> 5, c16 = idx & 31;
        const v4u vv = *(const GAS v4u*)(VT + (size_t)(h * HD + row) * 2048 + b * MEM + c16 * 8); *(LAS v4u*)(F.lds + VOFF + row * VST + c16 * 16) = vv; }
    const int q = F.lane & 15, quad = F.lane >> 4;
    bf16x8 qn[4];
    { const int tok = b * T + part * 512 + F.wave * 16 + q;
#pragma unroll
      for (int s = 0; s < 4; ++s) qn[s] = *(const GAS bf16x8*)(P + (size_t)tok * INC + 3072 + h * HD + s * 32 + quad * 8); }
    __syncthreads();
#pragma unroll 1
    for (int round = 0; round < 4; ++round) {
        const int tok = b * T + part * 512 + round * 128 + F.wave * 16 + q;
        bf16x8 qf[4];
#pragma unroll
        for (int s = 0; s < 4; ++s) qf[s] = qn[s];
        if (round < 3) { const int tn = tok + 128;
#pragma unroll
            for (int s = 0; s < 4; ++s) qn[s] = *(const GAS bf16x8*)(P + (size_t)tn * INC + 3072 + h * HD + s * 32 + quad * 8); }
        f32x4 sacc[16];
#pragma unroll
        for (int kb = 0; kb < 16; ++kb) { sacc[kb] = (f32x4){0.f, 0.f, 0.f, 0.f};
#pragma unroll
            for (int s = 0; s < 4; ++s) { const bf16x8 kf = *(const LAS bf16x8*)(F.lds + (kb * 16 + q) * KST + (s * 32 + quad * 8) * 2);
                sacc[kb] = __builtin_amdgcn_mfma_f32_16x16x32_bf16(kf, qf[s], sacc[kb], 0, 0, 0); }
            if (kb & 1) __builtin_amdgcn_sched_barrier(0); }
        float mx = -3.0e38f;
#pragma unroll
        for (int kb = 0; kb < 16; ++kb) mx = fmaxf(fmaxf(fmaxf(sacc[kb][0], sacc[kb][1]), fmaxf(sacc[kb][2], sacc[kb][3])), mx);
        mx = fmaxf(mx, __shfl_xor(mx, 16)); mx = fmaxf(mx, __shfl_xor(mx, 32));
        float sum = 0.f;
#pragma unroll
        for (int kb = 0; kb < 16; ++kb)
#pragma unroll
            for (int j = 0; j < 4; ++j) { const float pv = fast_exp2(sacc[kb][j] - mx); sacc[kb][j] = pv; sum += pv; }
        sum += __shfl_xor(sum, 16); sum += __shfl_xor(sum, 32);
        const float rs = 1.0f / sum;
        bf16x8 pf[8];
#pragma unroll
        for (int s2 = 0; s2 < 8; ++s2) { v4u w; w.x = pk2(sacc[2 * s2][0], sacc[2 * s2][1]); w.y = pk2(sacc[2 * s2][2], sacc[2 * s2][3]);
            w.z = pk2(sacc[2 * s2 + 1][0], sacc[2 * s2 + 1][1]); w.w = pk2(sacc[2 * s2 + 1][2], sacc[2 * s2 + 1][3]); pf[s2] = __builtin_bit_cast(bf16x8, w); }
        float ssq = 0.f;
#pragma unroll
        for (int db = 0; db < 8; ++db) { f32x4 o = (f32x4){0.f, 0.f, 0.f, 0.f};
#pragma unroll
            for (int s2 = 0; s2 < 8; ++s2) { const LAS unsigned char* vp = F.lds + VOFF + (db * 16 + q) * VST + (s2 * 32 + quad * 4) * 2;
                const v2u lo = *(const LAS v2u*)vp, hi = *(const LAS v2u*)(vp + 32);
                v4u w; w.x = lo.x; w.y = lo.y; w.z = hi.x; w.w = hi.y;
                o = __builtin_amdgcn_mfma_f32_16x16x32_bf16(__builtin_bit_cast(bf16x8, w), pf[s2], o, 0, 0, 0); }
            o = o * rs; ssq += (o[0] * o[0] + o[1] * o[1]) + (o[2] * o[2] + o[3] * o[3]);
            v2u w; w.x = pk2(o[0], o[1]); w.y = pk2(o[2], o[3]);
            *(GAS v2u*)(YB + (size_t)tok * D + 1536 + h * HD + db * 16 + quad * 4) = w;
            __builtin_amdgcn_sched_barrier(0); }
        ssq += __shfl_xor(ssq, 16); ssq += __shfl_xor(ssq, 32);
        if (quad == 0) atomicAdd(ssx + tok, (unsigned long long)(ssq * SS_SCALE + 0.5f));
    }
    __syncthreads();
}

__device__ __forceinline__ void gmlp_unit(Frame& F, int b, int c) {
    constexpr int VST = 272, GST = 128 * VST;
    const bf16* P = (const bf16*)(F.ws + WS_P); bf16* YB = (bf16*)(F.ws + WS_YBUF); unsigned long long* ssg = (unsigned long long*)(F.ws + (F.rep ? WS_DUMMY : CTL_SS)) + NTOK;
    const bf16* WSP = (const bf16*)(F.ws + WS_WSP);
    const int tok0 = b * T + c * 128, w = F.wave, lane = F.lane;
    const int q = lane & 15, quad = lane >> 4, t = w * 16 + q, tok = tok0 + t;
    float gv[8];
    { const float* gp = inp(F, I_GMVG) + 8 * lane;
#pragma unroll
      for (int e = 0; e < 8; ++e) gv[e] = gp[e]; }
#pragma unroll
    for (int half = 0; half < 2; ++half) {
        v4u raw[8];
#pragma unroll
        for (int i = 0; i < 8; ++i) raw[i] = *(const GAS v4u*)(P + (size_t)(tok0 + w * 16 + half * 8 + i) * INC + 2560 + 8 * lane);
#pragma unroll
        for (int i = 0; i < 8; ++i) { const int s = w * 16 + half * 8 + i;
            float f[8] = {bflo(raw[i].x), bfhi(raw[i].x), bflo(raw[i].y), bfhi(raw[i].y), bflo(raw[i].z), bfhi(raw[i].z), bflo(raw[i].w), bfhi(raw[i].w)};
            float ssq = 0.f;
#pragma unroll
            for (int e = 0; e < 8; ++e) ssq += f[e] * f[e];
            const float r = 1.0f / __builtin_sqrtf(wave_sum(ssq) * (1.0f / GMW) + EPS);
            LAS unsigned char* dst = F.lds + (lane >> 4) * GST + ((lane & 15) * 8) * VST + s * 2;
#pragma unroll
            for (int e = 0; e < 8; ++e) *(LAS bf16*)(dst + e * VST) = (bf16)f2bf(f[e] * r * gv[e]); }
    }
    __syncthreads();
    float ssq = 0.f;
#pragma unroll 1
    for (int g = 0; g < 4; ++g) {
        bf16x8 wf[4];
#pragma unroll
        for (int ks = 0; ks < 4; ++ks) wf[ks] = *(const GAS bf16x8*)(WSP + ((size_t)g * 128 + t) * 128 + ks * 32 + quad * 8);
        const float bs = inp(F, I_BSP)[g * 128 + t];
        v2u guv[8];
#pragma unroll
        for (int db = 0; db < 8; ++db) guv[db] = *(const GAS v2u*)(P + (size_t)tok * INC + 2048 + g * HD + db * 16 + quad * 4);
#pragma unroll
        for (int db = 0; db < 8; ++db) { f32x4 a = (f32x4){0.f, 0.f, 0.f, 0.f};
#pragma unroll
            for (int ks = 0; ks < 4; ++ks) { const bf16x8 vf = *(const LAS bf16x8*)(F.lds + g * GST + (db * 16 + q) * VST + (ks * 32 + quad * 8) * 2);
                a = __builtin_amdgcn_mfma_f32_16x16x32_bf16(vf, wf[ks], a, 0, 0, 0); }
            const v2u gu = guv[db];
            const float y0 = bflo(gu.x) * (a[0] + bs), y1 = bfhi(gu.x) * (a[1] + bs), y2 = bflo(gu.y) * (a[2] + bs), y3 = bfhi(gu.y) * (a[3] + bs);
            ssq += (y0 * y0 + y1 * y1) + (y2 * y2 + y3 * y3);
            v2u o; o.x = pk2(y0, y1); o.y = pk2(y2, y3);
            *(GAS v2u*)(YB + (size_t)tok * D + 1024 + g * HD + db * 16 + quad * 4) = o; }
    }
    ssq += __shfl_xor(ssq, 16); ssq += __shfl_xor(ssq, 32);
    if (quad == 0) atomicAdd(ssg + tok, (unsigned long long)(ssq * SS_SCALE + 0.5f));
    __syncthreads();
}

template <bool FINAL> __device__ __forceinline__ void rg_unit(Frame& F, int b, int c, int h) {
    constexpr int XST = 272, GOFF = 128 * XST, YOFF = 2 * 128 * XST;
    const bf16* P = (const bf16*)(F.ws + WS_P); bf16* YB = (bf16*)(F.ws + WS_YBUF); unsigned long long* ssr = (unsigned long long*)(F.ws + (F.rep ? WS_DUMMY : CTL_SS));
    const bf16* WaT = (const bf16*)(F.ws + WS_WA) + h * 16384; const bf16* WiT = (const bf16*)(F.ws + WS_WI) + h * 16384;
    float* Aend = (float*)(F.ws + WS_CARRY); float* Hend = Aend + NB * NCHUNK * RGW;
    const int tok0 = b * T + c * 128, w = F.wave, lane = F.lane, tid = F.tid;
    { const int cg = tid & 15, tq = tid >> 4, ch0 = h * HD + cg * 8;
      float cw[4][8], cb[8];
#pragma unroll
      for (int j = 0; j < 4; ++j) { const f32x4 a0 = *(const GAS f32x4*)(inp(F, I_CONVW) + j * RGW + ch0), a1 = *(const GAS f32x4*)(inp(F, I_CONVW) + j * RGW + ch0 + 4);
          cw[j][0] = a0[0]; cw[j][1] = a0[1]; cw[j][2] = a0[2]; cw[j][3] = a0[3]; cw[j][4] = a1[0]; cw[j][5] = a1[1]; cw[j][6] = a1[2]; cw[j][7] = a1[3]; }
      { const f32x4 a0 = *(const GAS f32x4*)(inp(F, I_CONVB) + ch0), a1 = *(const GAS f32x4*)(inp(F, I_CONVB) + ch0 + 4);
          cb[0] = a0[0]; cb[1] = a0[1]; cb[2] = a0[2]; cb[3] = a0[3]; cb[4] = a1[0]; cb[5] = a1[1]; cb[6] = a1[2]; cb[7] = a1[3]; }
      v4u raw[7];
#pragma unroll
      for (int r = 0; r < 7; ++r) { const int trow = c * 128 + tq * 4 - 3 + r;
          raw[r] = (trow >= 0) ? *(const GAS v4u*)(P + (size_t)(b * T + trow) * INC + ch0) : (v4u){0u, 0u, 0u, 0u}; }
#pragma unroll
      for (int tt = 0; tt < 4; ++tt) { float o[8];
#pragma unroll
          for (int e = 0; e < 8; ++e) o[e] = cb[e];
#pragma unroll
          for (int j = 0; j < 4; ++j) { const v4u rw = raw[tt + j];
              const float f[8] = {bflo(rw.x), bfhi(rw.x), bflo(rw.y), bfhi(rw.y), bflo(rw.z), bfhi(rw.z), bflo(rw.w), bfhi(rw.w)};
#pragma unroll
              for (int e = 0; e < 8; ++e) o[e] += cw[j][e] * f[e]; }
          v4u wv; wv.x = pk2(o[0], o[1]); wv.y = pk2(o[2], o[3]); wv.z = pk2(o[4], o[5]); wv.w = pk2(o[6], o[7]);
          *(LAS v4u*)(F.lds + (tq * 4 + tt) * XST + cg * 16) = wv; }
      if (FINAL) {
#pragma unroll
          for (int p = 0; p < 4; ++p) { const int idx = tid + 512 * p, row = idx >> 4, c16 = idx & 15;
              const v4u gvv = *(const GAS v4u*)(P + (size_t)(tok0 + row) * INC + RGW + h * HD + c16 * 8); *(LAS v4u*)(F.lds + GOFF + row * XST + c16 * 16) = gvv; } }
    }
    __syncthreads();
    const int q = lane & 15, quad = lane >> 4, ch = w * 16 + q, gc = h * HD + ch;
    bf16x8 waf[4], wif[4];
#pragma unroll
    for (int ks = 0; ks < 4; ++ks) { waf[ks] = *(const GAS bf16x8*)(WaT + (size_t)ch * 128 + ks * 32 + quad * 8); wif[ks] = *(const GAS bf16x8*)(WiT + (size_t)ch * 128 + ks * 32 + quad * 8); }
    f32x4 ar[8], ai[8];
#pragma unroll
    for (int tb = 0; tb < 8; ++tb) { ar[tb] = (f32x4){0.f, 0.f, 0.f, 0.f}; ai[tb] = (f32x4){0.f, 0.f, 0.f, 0.f};
#pragma unroll
        for (int ks = 0; ks < 4; ++ks) { const bf16x8 xf = *(const LAS bf16x8*)(F.lds + (tb * 16 + q) * XST + (ks * 32 + quad * 8) * 2);
            ar[tb] = __builtin_amdgcn_mfma_f32_16x16x32_bf16(xf, waf[ks], ar[tb], 0, 0, 0);
            ai[tb] = __builtin_amdgcn_mfma_f32_16x16x32_bf16(xf, wif[ks], ai[tb], 0, 0, 0); } }
    const float ba = inp(F, I_BRGA)[gc], bi = inp(F, I_BRGI)[gc];
    const float lam = inp(F, I_LAM)[gc];
    const float sp8 = 8.0f * log1pf(__expf(-lam));
#pragma unroll
    for (int tb = 0; tb < 8; ++tb)
#pragma unroll
        for (int tt = 0; tt < 4; ++tt) { const int t = tb * 16 + quad * 4 + tt;
            const float r = sigmoidf_(ar[tb][tt] + ba), ig = sigmoidf_(ai[tb][tt] + bi);
            const float la = -sp8 * r, a = __expf(la), t2 = 2.0f * la;
            const float om = (t2 > -0.05f) ? -t2 * (1.0f + t2 * (0.5f + t2 * (0.16666667f + t2 * 0.041666668f))) : 1.0f - __expf(t2);
            const float xcv = bf2f(*(const LAS bf16*)(F.lds + t * XST + ch * 2));
            ar[tb][tt] = a; ai[tb][tt] = __builtin_amdgcn_sqrtf(om) * ig * xcv; }
    float carry = 0.f, PC = 1.f;
    if (FINAL) {
#pragma unroll
        for (int base = 0; base < NCHUNK; base += 8) {
            if (base < c) { float cA[8], cH[8];
#pragma unroll
                for (int j = 0; j < 8; ++j) { const int cs = (base + j < c) ? base + j : c - 1; cA[j] = Aend[(b * NCHUNK + cs) * RGW + gc]; cH[j] = Hend[(b * NCHUNK + cs) * RGW + gc]; }
#pragma unroll
                for (int j = 0; j < 8; ++j) if (base + j < c) carry = cH[j] + cA[j] * carry; } } }
#pragma unroll
    for (int tb = 0; tb < 8; ++tb) {
        const float a0 = ar[tb][0], a1 = ar[tb][1], a2 = ar[tb][2], a3 = ar[tb][3], u0 = ai[tb][0], u1 = ai[tb][1], u2 = ai[tb][2], u3 = ai[tb][3];
        float Pl = a0 * a1 * a2 * a3, Hl = ((u0 * a1 + u1) * a2 + u2) * a3 + u3;
        { const float Pp = __shfl_up(Pl, 16), Hp = __shfl_up(Hl, 16); if (quad >= 1) { Hl = Hp * Pl + Hl; Pl = Pp * Pl; } }
        { const float Pp = __shfl_up(Pl, 32), Hp = __shfl_up(Hl, 32); if (quad >= 2) { Hl = Hp * Pl + Hl; Pl = Pp * Pl; } }
        float Pe = __shfl_up(Pl, 16), He = __shfl_up(Hl, 16); if (quad == 0) { Pe = 1.f; He = 0.f; }
        const float PB = __shfl(Pl, 48 + q), HB = __shfl(Hl, 48 + q);
        if (FINAL) {
            float hp = He + Pe * carry;
            const float g0 = bf2f(*(const LAS bf16*)(F.lds + GOFF + (tb * 16 + quad * 4 + 0) * XST + ch * 2)), g1 = bf2f(*(const LAS bf16*)(F.lds + GOFF + (tb * 16 + quad * 4 + 1) * XST + ch * 2));
            const float g2 = bf2f(*(const LAS bf16*)(F.lds + GOFF + (tb * 16 + quad * 4 + 2) * XST + ch * 2)), g3 = bf2f(*(const LAS bf16*)(F.lds + GOFF + (tb * 16 + quad * 4 + 3) * XST + ch * 2));
            hp = a0 * hp + u0; *(LAS bf16*)(F.lds + YOFF + (tb * 16 + quad * 4 + 0) * XST + ch * 2) = (bf16)f2bf(g0 * hp);
            hp = a1 * hp + u1; *(LAS bf16*)(F.lds + YOFF + (tb * 16 + quad * 4 + 1) * XST + ch * 2) = (bf16)f2bf(g1 * hp);
            hp = a2 * hp + u2; *(LAS bf16*)(F.lds + YOFF + (tb * 16 + quad * 4 + 2) * XST + ch * 2) = (bf16)f2bf(g2 * hp);
            hp = a3 * hp + u3; *(LAS bf16*)(F.lds + YOFF + (tb * 16 + quad * 4 + 3) * XST + ch * 2) = (bf16)f2bf(g3 * hp);
            carry = HB + PB * carry;
        } else { carry = HB + PB * carry; PC = PC * PB; }
    }
    if (!FINAL) { if (quad == 0) { Aend[(b * NCHUNK + c) * RGW + gc] = PC; Hend[(b * NCHUNK + c) * RGW + gc] = carry; } }
    else {
        __syncthreads();
        float ssq = 0.f; const int row = tid >> 2, q4 = tid & 3;
#pragma unroll
        for (int p = 0; p < 4; ++p) { const int c16 = p * 4 + q4;     const v4u yv = *(const LAS v4u*)(F.lds + YOFF + row * XST + c16 * 16);
            *(GAS v4u*)(YB + (size_t)(tok0 + row) * D + h * HD + c16 * 8) = yv;
            const float f[8] = {bflo(yv.x), bfhi(yv.x), bflo(yv.y), bfhi(yv.y), bflo(yv.z), bfhi(yv.z), bflo(yv.w), bfhi(yv.w)};
#pragma unroll
            for (int e = 0; e < 8; ++e) ssq += f[e] * f[e]; }
        ssq += __shfl_xor(ssq, 1); ssq += __shfl_xor(ssq, 2);
        if (q4 == 0) atomicAdd(ssr + tok0 + row, (unsigned long long)(ssq * SS_SCALE + 0.5f));
    }
    __syncthreads();
}

__device__ __forceinline__ void rg_unit_lb(Frame& F, int b, int c, int h) {
    constexpr bool FINAL = true;
    constexpr int XST = 272, GOFF = 128 * XST, YOFF = 2 * 128 * XST;
    const bf16* P = (const bf16*)(F.ws + WS_P); bf16* YB = (bf16*)(F.ws + WS_YBUF); unsigned long long* ssr = (unsigned long long*)(F.ws + (F.rep ? WS_DUMMY : CTL_SS));
    const bf16* WaT = (const bf16*)(F.ws + WS_WA) + h * 16384; const bf16* WiT = (const bf16*)(F.ws + WS_WI) + h * 16384;
    typedef GAS unsigned long long gu64;
    gu64* GA = (gu64*)(F.ws + WS_GRAN); gu64* GH = GA + NB * NCHUNK * RGW;
    const int tok0 = b * T + c * 128, w = F.wave, lane = F.lane, tid = F.tid;
    const int q = lane & 15, quad = lane >> 4, ch = w * 16 + q, gc = h * HD + ch;
    bf16x8 waf[4], wif[4];
#pragma unroll
    for (int ks = 0; ks < 4; ++ks) { waf[ks] = *(const GAS bf16x8*)(WaT + (size_t)ch * 128 + ks * 32 + quad * 8); wif[ks] = *(const GAS bf16x8*)(WiT + (size_t)ch * 128 + ks * 32 + quad * 8); }
    const float ba = inp(F, I_BRGA)[gc], bi = inp(F, I_BRGI)[gc];
    const float lam = inp(F, I_LAM)[gc];
    const float sp8 = 8.0f * log1pf(__expf(-lam));
    { const int cg = tid & 15, tq = tid >> 4, ch0 = h * HD + cg * 8;
      float cw[4][8], cb[8];
#pragma unroll
      for (int j = 0; j < 4; ++j) { const f32x4 a0 = *(const GAS f32x4*)(inp(F, I_CONVW) + j * RGW + ch0), a1 = *(const GAS f32x4*)(inp(F, I_CONVW) + j * RGW + ch0 + 4);
          cw[j][0] = a0[0]; cw[j][1] = a0[1]; cw[j][2] = a0[2]; cw[j][3] = a0[3]; cw[j][4] = a1[0]; cw[j][5] = a1[1]; cw[j][6] = a1[2]; cw[j][7] = a1[3]; }
      { const f32x4 a0 = *(const GAS f32x4*)(inp(F, I_CONVB) + ch0), a1 = *(const GAS f32x4*)(inp(F, I_CONVB) + ch0 + 4);
          cb[0] = a0[0]; cb[1] = a0[1]; cb[2] = a0[2]; cb[3] = a0[3]; cb[4] = a1[0]; cb[5] = a1[1]; cb[6] = a1[2]; cb[7] = a1[3]; }
      v4u raw[7];
#pragma unroll
      for (int r = 0; r < 7; ++r) { const int trow = c * 128 + tq * 4 - 3 + r;
          raw[r] = (trow >= 0) ? *(const GAS v4u*)(P + (size_t)(b * T + trow) * INC + ch0) : (v4u){0u, 0u, 0u, 0u}; }
#pragma unroll
      for (int tt = 0; tt < 4; ++tt) { float o[8];
#pragma unroll
          for (int e = 0; e < 8; ++e) o[e] = cb[e];
#pragma unroll
          for (int j = 0; j < 4; ++j) { const v4u rw = raw[tt + j];
              const float f[8] = {bflo(rw.x), bfhi(rw.x), bflo(rw.y), bfhi(rw.y), bflo(rw.z), bfhi(rw.z), bflo(rw.w), bfhi(rw.w)};
#pragma unroll
              for (int e = 0; e < 8; ++e) o[e] += cw[j][e] * f[e]; }
          v4u wv; wv.x = pk2(o[0], o[1]); wv.y = pk2(o[2], o[3]); wv.z = pk2(o[4], o[5]); wv.w = pk2(o[6], o[7]);
          *(LAS v4u*)(F.lds + (tq * 4 + tt) * XST + cg * 16) = wv; }
      if (FINAL) {
#pragma unroll
          for (int p = 0; p < 4; ++p) { const int idx = tid + 512 * p, row = idx >> 4, c16 = idx & 15;
              const v4u gvv = *(const GAS v4u*)(P + (size_t)(tok0 + row) * INC + RGW + h * HD + c16 * 8); *(LAS v4u*)(F.lds + GOFF + row * XST + c16 * 16) = gvv; } }
    }
    __syncthreads();
    f32x4 ar[8], ai[8];
#pragma unroll
    for (int tb = 0; tb < 8; ++tb) { ar[tb] = (f32x4){0.f, 0.f, 0.f, 0.f}; ai[tb] = (f32x4){0.f, 0.f, 0.f, 0.f};
#pragma unroll
        for (int ks = 0; ks < 4; ++ks) { const bf16x8 xf = *(const LAS bf16x8*)(F.lds + (tb * 16 + q) * XST + (ks * 32 + quad * 8) * 2);
            ar[tb] = __builtin_amdgcn_mfma_f32_16x16x32_bf16(xf, waf[ks], ar[tb], 0, 0, 0);
            ai[tb] = __builtin_amdgcn_mfma_f32_16x16x32_bf16(xf, wif[ks], ai[tb], 0, 0, 0); } }
#pragma unroll
    for (int tb = 0; tb < 8; ++tb)
#pragma unroll
        for (int tt = 0; tt < 4; ++tt) { const int t = tb * 16 + quad * 4 + tt;
            const float r = sigmoidf_(ar[tb][tt] + ba), ig = sigmoidf_(ai[tb][tt] + bi);
            const float la = -sp8 * r, a = __expf(la), t2 = 2.0f * la;
            const float om = (t2 > -0.05f) ? -t2 * (1.0f + t2 * (0.5f + t2 * (0.16666667f + t2 * 0.041666668f))) : 1.0f - __expf(t2);
            const float xcv = bf2f(*(const LAS bf16*)(F.lds + t * XST + ch * 2));
            ar[tb][tt] = a; ai[tb][tt] = __builtin_amdgcn_sqrtf(om) * ig * xcv; }
    float Pe[8], He[8], PB[8], HB[8]; float PC = 1.f, HC = 0.f;
#pragma unroll
    for (int tb = 0; tb < 8; ++tb) {
        const float a0 = ar[tb][0], a1 = ar[tb][1], a2 = ar[tb][2], a3 = ar[tb][3], u0 = ai[tb][0], u1 = ai[tb][1], u2 = ai[tb][2], u3 = ai[tb][3];
        float Pl = a0 * a1 * a2 * a3, Hl = ((u0 * a1 + u1) * a2 + u2) * a3 + u3;
        { const float Pp = __shfl_up(Pl, 16), Hp = __shfl_up(Hl, 16); if (quad >= 1) { Hl = Hp * Pl + Hl; Pl = Pp * Pl; } }
        { const float Pp = __shfl_up(Pl, 32), Hp = __shfl_up(Hl, 32); if (quad >= 2) { Hl = Hp * Pl + Hl; Pl = Pp * Pl; } }
        float pe = __shfl_up(Pl, 16), he = __shfl_up(Hl, 16); if (quad == 0) { pe = 1.f; he = 0.f; }
        Pe[tb] = pe; He[tb] = he; PB[tb] = __shfl(Pl, 48 + q); HB[tb] = __shfl(Hl, 48 + q);
        HC = HB[tb] + PB[tb] * HC; PC = PC * PB[tb];
    }
    if (quad == 0) {
        __hip_atomic_store(GA + (size_t)(b * NCHUNK + c) * RGW + gc, (1ull << 32) | (unsigned long long)__builtin_bit_cast(unsigned, PC), __ATOMIC_RELAXED, __HIP_MEMORY_SCOPE_AGENT);
        __hip_atomic_store(GH + (size_t)(b * NCHUNK + c) * RGW + gc, (1ull << 32) | (unsigned long long)__builtin_bit_cast(unsigned, HC), __ATOMIC_RELAXED, __HIP_MEMORY_SCOPE_AGENT); }
    float carry = 0.f;
    { unsigned* tmo = (unsigned*)(F.ws + WS_CTL) + 8; unsigned spins = 0;
#pragma unroll
      for (int base = 0; base < NCHUNK; base += 8) {
        if (base < c) { unsigned long long gA[8], gH[8];
            for (;;) { bool ok = true;
#pragma unroll
                for (int j = 0; j < 8; ++j) { const int cs = (base + j < c) ? base + j : c - 1;
                    gA[j] = __hip_atomic_load(GA + (size_t)(b * NCHUNK + cs) * RGW + gc, __ATOMIC_RELAXED, __HIP_MEMORY_SCOPE_AGENT);
                    gH[j] = __hip_atomic_load(GH + (size_t)(b * NCHUNK + cs) * RGW + gc, __ATOMIC_RELAXED, __HIP_MEMORY_SCOPE_AGENT);
                    ok = ok && ((gA[j] >> 32) == 1ull) && ((gH[j] >> 32) == 1ull); }
                if (__all(ok)) break;
                __builtin_amdgcn_s_sleep(2);
                if (++spins > (1u << 16)) { if (lane == 0) __hip_atomic_store(tmo, 1u, __ATOMIC_RELAXED, __HIP_MEMORY_SCOPE_AGENT); break; }
                if ((spins & 63u) == 0u && __hip_atomic_load(tmo, __ATOMIC_RELAXED, __HIP_MEMORY_SCOPE_AGENT) != 0u) break; }
#pragma unroll
            for (int j = 0; j < 8; ++j) if (base + j < c) carry = __builtin_bit_cast(float, (unsigned)gH[j]) + __builtin_bit_cast(float, (unsigned)gA[j]) * carry; } } }
#pragma unroll
    for (int tb = 0; tb < 8; ++tb) {
        const float a0 = ar[tb][0], a1 = ar[tb][1], a2 = ar[tb][2], a3 = ar[tb][3], u0 = ai[tb][0], u1 = ai[tb][1], u2 = ai[tb][2], u3 = ai[tb][3];
        float hp = He[tb] + Pe[tb] * carry;
        const float g0 = bf2f(*(const LAS bf16*)(F.lds + GOFF + (tb * 16 + quad * 4 + 0) * XST + ch * 2)), g1 = bf2f(*(const LAS bf16*)(F.lds + GOFF + (tb * 16 + quad * 4 + 1) * XST + ch * 2));
        const float g2 = bf2f(*(const LAS bf16*)(F.lds + GOFF + (tb * 16 + quad * 4 + 2) * XST + ch * 2)), g3 = bf2f(*(const LAS bf16*)(F.lds + GOFF + (tb * 16 + quad * 4 + 3) * XST + ch * 2));
        hp = a0 * hp + u0; *(LAS bf16*)(F.lds + YOFF + (tb * 16 + quad * 4 + 0) * XST + ch * 2) = (bf16)f2bf(g0 * hp);
        hp = a1 * hp + u1; *(LAS bf16*)(F.lds + YOFF + (tb * 16 + quad * 4 + 1) * XST + ch * 2) = (bf16)f2bf(g1 * hp);
        hp = a2 * hp + u2; *(LAS bf16*)(F.lds + YOFF + (tb * 16 + quad * 4 + 2) * XST + ch * 2) = (bf16)f2bf(g2 * hp);
        hp = a3 * hp + u3; *(LAS bf16*)(F.lds + YOFF + (tb * 16 + quad * 4 + 3) * XST + ch * 2) = (bf16)f2bf(g3 * hp);
        carry = HB[tb] + PB[tb] * carry;
    }
    {
        __syncthreads();
        float ssq = 0.f; const int row = tid >> 2, q4 = tid & 3;
#pragma unroll
        for (int p = 0; p < 4; ++p) { const int c16 = p * 4 + q4;     const v4u yv = *(const LAS v4u*)(F.lds + YOFF + row * XST + c16 * 16);
            *(GAS v4u*)(YB + (size_t)(tok0 + row) * D + h * HD + c16 * 8) = yv;
            const float f[8] = {bflo(yv.x), bfhi(yv.x), bflo(yv.y), bfhi(yv.y), bflo(yv.z), bfhi(yv.z), bflo(yv.w), bfhi(yv.w)};
#pragma unroll
            for (int e = 0; e < 8; ++e) ssq += f[e] * f[e]; }
        ssq += __shfl_xor(ssq, 1); ssq += __shfl_xor(ssq, 2);
        if (q4 == 0) atomicAdd(ssr + tok0 + row, (unsigned long long)(ssq * SS_SCALE + 0.5f));
    }
    __syncthreads();
}

__device__ __forceinline__ void router_phase(Frame& F) {
    const bf16* Hh = (const bf16*)(F.ws + WS_H); unsigned char* HN = F.ws + WS_HN; const float* WRP = (const float*)(F.ws + WS_WRP);
    int* TOPI = (int*)(F.ws + WS_TOPI); float* TOPG = (float*)(F.ws + WS_TOPG); float* RSTD = (float*)(F.ws + WS_RSTD);
    constexpr int PSZ = 8 * 32 * 33;
    LAS float* part = (LAS float*)F.lds;
    LAS float* ssqp = part + 4 * PSZ;
    LAS float* lg = ssqp + 4 * 256;
    const int w = F.wave, lane = F.lane, m = lane & 31, kk = lane >> 5;
    f32x4 bw[32];
#pragma unroll
    for (int i = 0; i < 32; ++i) bw[i] = *(const GAS f32x4*)(WRP + ((size_t)(64 * w + 32 * kk + i) * 32 + m) * 4);
    const int ntile = (NTOK / 32 - F.bx + F.G - 1) / F.G;
    for (int j0 = 0; j0 < ntile; j0 += 4) {
        const int nj = (ntile - j0) < 4 ? (ntile - j0) : 4;
        for (int ts = 0; ts < nj; ++ts) {
            const int tile = F.bx + F.G * (j0 + ts), tok0 = tile * 32;
            const bf16* hrow = Hh + (size_t)(tok0 + m) * D + 256 * w + 128 * kk;
            float ssq = 0.f;
            f32x16 acc;
#pragma unroll
            for (int r = 0; r < 16; ++r) acc[r] = 0.f;
            v4u a0[4], a1[4];
#pragma unroll
            for (int i = 0; i < 4; ++i) a0[i] = *(const GAS v4u*)(hrow + 8 * i);
#pragma unroll
            for (int ib = 0; ib < 4; ++ib) {
                if (ib < 3) {
#pragma unroll
                    for (int i = 0; i < 4; ++i) { if (ib & 1) a0[i] = *(const GAS v4u*)(hrow + 8 * (4 * (ib + 1) + i)); else a1[i] = *(const GAS v4u*)(hrow + 8 * (4 * (ib + 1) + i)); } }
#pragma unroll
                for (int i = 0; i < 4; ++i) { const v4u q = (ib & 1) ? a1[i] : a0[i];
                    const float av[8] = {bflo(q.x), bfhi(q.x), bflo(q.y), bfhi(q.y), bflo(q.z), bfhi(q.z), bflo(q.w), bfhi(q.w)};
#pragma unroll
                    for (int e = 0; e < 8; ++e) { ssq += av[e] * av[e]; acc = __builtin_amdgcn_mfma_f32_32x32x2f32(av[e], bw[ib * 8 + 2 * i + (e >> 2)][e & 3], acc, 0, 0, 0); } }
            }
            ssq += __shfl_xor(ssq, 32);
#pragma unroll
            for (int r = 0; r < 16; ++r) { const int mr = (r & 3) + 8 * (r >> 2) + 4 * kk; part[ts * PSZ + (w * 32 + mr) * 33 + m] = acc[r]; }
            if (lane < 32) ssqp[ts * 256 + w * 32 + m] = ssq;
        }
        for (int ts = 0; ts < nj; ++ts)
#pragma unroll 1
            for (int rr = 0; rr < 4; ++rr) { const int tok = (F.bx + F.G * (j0 + ts)) * 32 + 4 * w + rr;
                const bf16* hp = Hh + (size_t)tok * D + 32 * lane; float x[32];
#pragma unroll
                for (int i = 0; i < 4; ++i) { const v4u q = *(const GAS v4u*)(hp + 8 * i);
                    x[8 * i] = bflo(q.x); x[8 * i + 1] = bfhi(q.x); x[8 * i + 2] = bflo(q.y); x[8 * i + 3] = bfhi(q.y); x[8 * i + 4] = bflo(q.z); x[8 * i + 5] = bfhi(q.z); x[8 * i + 6] = bflo(q.w); x[8 * i + 7] = bfhi(q.w); }
                v4u lo, hi; pack_fp6(x, lo, hi);
                unsigned char* op = HN + (size_t)tok * D + 128 * (lane >> 2) + 16 * (lane & 3);
                *(GAS v4u*)op = lo; *(GAS v4u*)(op + 64) = hi; }
        __syncthreads();
        { const int tm = F.tid >> 2, e8 = (F.tid & 3) * 8, ts = tm >> 5, mm = tm & 31;
          if (ts < nj) {
            float sq = 0.f;
#pragma unroll
            for (int ww = 0; ww < 8; ++ww) sq += ssqp[ts * 256 + ww * 32 + mm];
            const float r = 1.0f / __builtin_sqrtf(sq * (1.0f / D) + EPS);
            float l[8];
#pragma unroll
            for (int e = 0; e < 8; ++e) l[e] = 0.f;
#pragma unroll
            for (int ww = 0; ww < 8; ++ww)
#pragma unroll
                for (int e = 0; e < 8; ++e) l[e] += part[ts * PSZ + (ww * 32 + mm) * 33 + e8 + e];
#pragma unroll
            for (int e = 0; e < 8; ++e) lg[tm * 33 + e8 + e] = l[e] * r + inp(F, I_BR)[e8 + e];
            if ((F.tid & 3) == 0) RSTD[(F.bx + F.G * (j0 + ts)) * 32 + mm] = r; } }
        __syncthreads();
        if (F.tid < 32 * nj) { const int tm = F.tid, ts = tm >> 5, mm = tm & 31; float v[32];
#pragma unroll
            for (int e = 0; e < 32; ++e) v[e] = lg[tm * 33 + e];
            int idx[4]; float val[4];
#pragma unroll
            for (int k = 0; k < 4; ++k) { float best = -3.0e38f; int bi = 0;
#pragma unroll
                for (int e = 0; e < 32; ++e) { const bool tk = v[e] > best; best = tk ? v[e] : best; bi = tk ? e : bi; }
                idx[k] = bi; val[k] = best;
#pragma unroll
                for (int e = 0; e < 32; ++e) v[e] = (e == bi) ? -3.0e38f : v[e]; }
            const float e0 = 1.0f, e1 = __expf(val[1] - val[0]), e2 = __expf(val[2] - val[0]), e3 = __expf(val[3] - val[0]);
            const float inv = 1.0f / (e0 + e1 + e2 + e3);
            const int tok = (F.bx + F.G * (j0 + ts)) * 32 + mm;
            *(GAS i32x4*)(TOPI + tok * 4) = (i32x4){idx[0], idx[1], idx[2], idx[3]};
            *(GAS f32x4*)(TOPG + tok * 4) = (f32x4){e0 * inv, e1 * inv, e2 * inv, e3 * inv};
            if (!F.rep)
#pragma unroll
            for (int k = 0; k < 4; ++k) (void)__hip_atomic_fetch_add((LAS unsigned*)(F.lds + LDSCTL_OFF) + LC_HIST + idx[k], 1u, __ATOMIC_RELAXED, __HIP_MEMORY_SCOPE_WORKGROUP);
        }
        __syncthreads();
    }
}

__device__ __forceinline__ void scatter_phase(Frame& F) {
    const int* CNT = (const int*)(F.ws + WS_CNTWG); const int* TOPI = (const int*)(F.ws + WS_TOPI); const float* TOPG = (const float*)(F.ws + WS_TOPG);
    int* INV = (int*)(F.ws + WS_INV); int* TOKS = (int*)(F.ws + WS_TOKS); float* GATES = (float*)(F.ws + WS_GATES); int* META = (int*)(F.ws + WS_META);
    const float* RSTD = (const float*)(F.ws + WS_RSTD); float* RSS = (float*)(F.ws + WS_RSS);
    LAS int* red = (LAS int*)F.lds;
    { const int e = F.tid & 31, part = F.tid >> 5; int sb = 0, sa = 0;
      for (int wg = part; wg < F.G; wg += 16) { const int v = CNT[wg * 32 + e]; sa += v; sb += (wg < F.bx) ? v : 0; }
      red[part * 32 + e] = sb; red[512 + part * 32 + e] = sa; }
    __syncthreads();
    if (F.tid < 32) { int sb = 0, sa = 0;
#pragma unroll
        for (int p = 0; p < 16; ++p) { sb += red[p * 32 + F.tid]; sa += red[512 + p * 32 + F.tid]; }
        F.LC[LC_BASE + F.tid] = (unsigned)sb; F.LC[LC_TOTAL + F.tid] = (unsigned)sa; }
    __syncthreads();
    if (F.tid == 0) { int acc = 0; for (int e = 0; e < NE; ++e) { F.LC[LC_TPRE + e] = (unsigned)acc; acc += ((int)F.LC[LC_TOTAL + e] + 255) >> 8; } F.LC[LC_TPRE + NE] = (unsigned)acc; }
    __syncthreads();
    if (F.bx == 0 && F.tid <= NE) META[F.tid] = (int)F.LC[LC_TPRE + F.tid];
    LAS int* wcnt = red;
    const int lane = F.lane, w = F.wave;
    const int ntile = (NTOK / 32 - F.bx + F.G - 1) / F.G;
    for (int j0 = 0; j0 < ntile; j0 += 4) {
        const int j = j0 + (F.tid >> 7), i = F.tid & 127, tile = F.bx + F.G * j;
        const bool valid = j < ntile;
        const int e = valid ? TOPI[tile * 128 + i] : -1;
        float gt = 0.f, rsd = 0.f; if (valid) { gt = TOPG[tile * 128 + i]; rsd = RSTD[tile * 32 + (i >> 2)]; }
        unsigned long long mine = 0ull; int cnt_e = 0;
#pragma unroll
        for (int x = 0; x < NE; ++x) { const unsigned long long m = __ballot(e == x); mine = (e == x) ? m : mine; cnt_e = (lane == x) ? __popcll(m) : cnt_e; }
        const int rank = __popcll(mine & ((1ull << lane) - 1ull));
        __syncthreads();
        if (lane < NE) wcnt[w * 32 + lane] = cnt_e;
        __syncthreads();
        if (F.tid < NE) { int acc = 0;
#pragma unroll
            for (int ww = 0; ww < 8; ++ww) { const int c = wcnt[ww * 32 + F.tid]; wcnt[ww * 32 + F.tid] = acc; acc += c; }
            wcnt[256 + F.tid] = acc; }
        __syncthreads();
        if (valid) { const int pos = 256 * (int)F.LC[LC_TPRE + e] + (int)F.LC[LC_BASE + e] + wcnt[w * 32 + e] + rank;
            TOKS[pos] = tile * 32 + (i >> 2); GATES[pos] = gt; RSS[pos] = rsd; INV[tile * 128 + i] = pos; }
        __syncthreads();
        if (F.tid < NE) F.LC[LC_BASE + F.tid] += (unsigned)wcnt[256 + F.tid];
    }
    __syncthreads();
    if (F.bx < NE) { const int e = F.bx, tot = (int)F.LC[LC_TOTAL + e], r0 = 256 * (int)F.LC[LC_TPRE + e], r1 = 256 * (int)F.LC[LC_TPRE + e + 1];
        for (int r = r0 + tot + F.tid; r < r1; r += 512) { TOKS[r] = 0; GATES[r] = 0.f; RSS[r] = 0.f; } }
}

__device__ __forceinline__ void final_row(Frame& F, float* outp, int tok) {
    const bf16* Hh = (const bf16*)(F.ws + WS_H); const unsigned char* YS = F.ws + WS_YS; const int* INV = (const int*)(F.ws + WS_INV);
    const int lane = F.lane;
    const i32x4 pos = *(const GAS i32x4*)(INV + tok * 4);
    const GAS v2u* hr = (const GAS v2u*)(Hh + (size_t)tok * D) + lane;
    const GAS unsigned* y0 = (const GAS unsigned*)(YS + (size_t)pos.x * D) + lane; const GAS unsigned* y1 = (const GAS unsigned*)(YS + (size_t)pos.y * D) + lane;
    const GAS unsigned* y2 = (const GAS unsigned*)(YS + (size_t)pos.z * D) + lane; const GAS unsigned* y3 = (const GAS unsigned*)(YS + (size_t)pos.w * D) + lane;
    f32x4 v[8]; float s = 0.f;
#pragma unroll
    for (int j = 0; j < 8; ++j) { const v2u hq_ = hr[64 * j]; const f32x4 hv = {bflo(hq_.x), bfhi(hq_.x), bflo(hq_.y), bfhi(hq_.y)}; const unsigned a = y0[64 * j], b = y1[64 * j], c = y2[64 * j], d = y3[64 * j];
        const f32x2 a0 = __builtin_amdgcn_cvt_pk_f32_fp8((int)a, false), a1 = __builtin_amdgcn_cvt_pk_f32_fp8((int)a, true), b0 = __builtin_amdgcn_cvt_pk_f32_fp8((int)b, false), b1 = __builtin_amdgcn_cvt_pk_f32_fp8((int)b, true);
        const f32x2 c0 = __builtin_amdgcn_cvt_pk_f32_fp8((int)c, false), c1 = __builtin_amdgcn_cvt_pk_f32_fp8((int)c, true), d0 = __builtin_amdgcn_cvt_pk_f32_fp8((int)d, false), d1 = __builtin_amdgcn_cvt_pk_f32_fp8((int)d, true);
        f32x4 mo;
        mo[0] = ((a0[0] + b0[0]) + c0[0]) + d0[0]; mo[1] = ((a0[1] + b0[1]) + c0[1]) + d0[1];
        mo[2] = ((a1[0] + b1[0]) + c1[0]) + d1[0]; mo[3] = ((a1[1] + b1[1]) + c1[1]) + d1[1];
        v[j] = hv + mo * 0.0625f; s += (v[j][0] * v[j][0] + v[j][1] * v[j][1]) + (v[j][2] * v[j][2] + v[j][3] * v[j][3]); }
    const float r = 1.0f / __builtin_sqrtf(wave_sum(s) * (1.0f / D) + EPS);
    GAS f32x4* o = (GAS f32x4*)(outp + (size_t)tok * D) + lane;
#pragma unroll
    for (int j = 0; j < 8; ++j) { const f32x4 gg = ((const GAS f32x4*)inp(F, I_FING))[lane + 64 * j]; o[64 * j] = v[j] * r * gg; }
}

__device__ __forceinline__ void ph1_gemms(Frame& F) {
    { pg8::DenseOrder S; S.init(NTOK, INC, F.G, F.bx, (const bf16*)(F.ws + WS_WIN));
      pg8::EpiInProj E{(bf16*)(F.ws + WS_P), 0.08838834764831845f * 1.4426950408889634f, (const float*)(F.ws + WS_RSTD0)};
      pg8::gemm_phase<0>(F.lds, F.ws + WS_XB, S, E, F.wave); }
    { pg8::DenseSplit8 S; S.init(NB * MEM, XAW, F.G, F.bx, (const bf16*)(F.ws + WS_WKT));
      pg8::EpiPartialF32 E{(bf16*)(F.ws + WS_KVP), 512, (size_t)NB * MEM * XAW};
      pg8::gemm_phase<0, 8>(F.lds, F.ws + WS_MEMN, S, E, F.wave); }
    { pg8::DenseSplit8 S; S.init(XAW, NB * MEM, F.G, (F.bx + F.G - 128 % F.G) % F.G, (const bf16*)(F.ws + WS_MEMN));
      pg8::EpiPartialF32 E{(bf16*)(F.ws + WS_KVP) + (size_t)8 * NB * MEM * XAW, 2048, (size_t)NB * MEM * XAW};
      pg8::gemm_phase<0, 8>(F.lds, F.ws + WS_WVT, S, E, F.wave); }
}
#ifndef P2_MASK
#define P2_MASK 7
#endif
#ifndef REP_P2MASK
#define REP_P2MASK 7
#endif
__device__ __forceinline__ void ph2_mixers(Frame& F) {
    { const bf16* KVP = (const bf16*)(F.ws + WS_KVP); bf16* KB = (bf16*)(F.ws + WS_KB); bf16* VT = (bf16*)(F.ws + WS_VT);
      constexpr int NOUT4 = NB * MEM * XAW / 4;
      for (int i = F.bx * 512 + F.tid; i < 2 * NOUT4; i += F.G * 512) { const int t = i >= NOUT4, j = t ? i - NOUT4 : i;
          const bf16* p = KVP + (size_t)t * 8 * NB * MEM * XAW + (size_t)j * 4; f32x4 a = {0.f, 0.f, 0.f, 0.f};
#pragma unroll
          for (int k = 0; k < 8; ++k) { const v2u q = *(const GAS v2u*)(p + (size_t)k * NB * MEM * XAW); a = a + (f32x4){bflo(q.x), bfhi(q.x), bflo(q.y), bfhi(q.y)}; }
          v2u o; o.x = pk2(a[0], a[1]); o.y = pk2(a[2], a[3]); *(GAS v2u*)((t ? VT : KB) + (size_t)j * 4) = o; } }
    const int pmask = F.rep ? REP_P2MASK : P2_MASK;
    if (pmask & 2) for (int u = F.bx; u < NB * NCHUNK; u += F.G) gmlp_unit(F, u >> 5, u & 31);
    if (pmask & 4) for (int u = F.bx; u < NB * NCHUNK * 8; u += F.G) rg_unit_lb(F, u >> 8, (u >> 3) & 31, u & 7);
}
__device__ __forceinline__ void ph3_rg_final(Frame& F) {
    if (P2_MASK & 1) for (int u = F.bx; u < NB * 4 * 8; u += F.G) xattn_unit(F, u >> 5, (u >> 3) & 3, u & 7);
}
__device__ __forceinline__ void ph4_outproj(Frame& F) {
    pg8::DenseOrder S; S.init(NTOK, D, F.G, F.bx, (const bf16*)(F.ws + WS_WOUT));
    const unsigned long long* ssp = (const unsigned long long*)(F.ws + CTL_SS);
    LAS float* fac = (LAS float*)(F.lds + pg8::STAGE_BYTES);
    int nu = 0; { pg8::Unit u; while (nu < 10 && S.next(nu, u)) ++nu; }
    for (int i = 0; i < nu; ++i) { pg8::Unit u; (void)S.next(i, u);
        if (F.tid < 256) { const int r = u.pm * 256 + F.tid; const float rg = (float)ssp[r], gm = (float)ssp[NTOK + r], xa = (float)ssp[2 * NTOK + r];
            fac[(i * 256 + F.tid) * 3 + 0] = __builtin_sqrtf((gm * (SS_INV / GMW) + EPS) / (rg * (SS_INV / RGW) + EPS));
            fac[(i * 256 + F.tid) * 3 + 1] = __builtin_sqrtf((xa * (SS_INV / XAW) + EPS) / (gm * (SS_INV / GMW) + EPS));
            fac[(i * 256 + F.tid) * 3 + 2] = 1.0f / __builtin_sqrtf(xa * (SS_INV / XAW) + EPS); } }
    __syncthreads();
    pg8::EpiOutProj E{(const bf16*)(F.ws + WS_XB), (bf16*)(F.ws + WS_H), ssp, (const LAS float*)fac};
    pg8::gemm_phase<0>(F.lds, F.ws + WS_YBUF, S, E, F.wave);
}
__device__ __forceinline__ void ph5_router(Frame& F) {
    router_phase(F);
    if (F.tid < NE && !F.rep) ((int*)(F.ws + WS_CNTWG))[F.bx * 32 + F.tid] = (int)F.LC[LC_HIST + F.tid];
}
__device__ __forceinline__ void ph7_gateup(Frame& F) {
    if (F.tid <= NE) F.LC[LC_TPRE + F.tid] = (unsigned)((const int*)(F.ws + WS_META))[F.tid];
    __syncthreads();
    pg8::GroupedOrder<true> S; S.nM = (int)F.LC[LC_TPRE + NE]; S.nN = 16; S.G = F.G; S.c = F.bx; S.Bt = F.ws + WS_WGU; S.tok = (const int*)(F.ws + WS_TOKS); S.tpre = (const volatile LAS int*)(F.LC + LC_TPRE);
    pg8::EpiGateUp E{F.ws + WS_ACT, inp(F, I_BGU), (const float*)(F.ws + WS_RSS), F.lds + pg8::STAGE_BYTES};
    pg8::gemm_phase<2>(F.lds, F.ws + WS_HN, S, E, F.wave);
}
__device__ __forceinline__ void ph8_down(Frame& F) {
    if (F.tid <= NE) F.LC[LC_TPRE + F.tid] = (unsigned)((const int*)(F.ws + WS_META))[F.tid];
    __syncthreads();
    pg8::GroupedOrder<false> S; S.nM = (int)F.LC[LC_TPRE + NE]; S.nN = 8; S.G = F.G; S.c = F.bx; S.Bt = F.ws + WS_WD; S.tok = nullptr; S.tpre = (const volatile LAS int*)(F.LC + LC_TPRE);
    pg8::EpiDown E{F.ws + WS_YS, inp(F, I_BD), (const float*)(F.ws + WS_GATES), F.lds + pg8::STAGE_BYTES};
    pg8::gemm_phase<1>(F.lds, F.ws + WS_ACT, S, E, F.wave);
}
__device__ __forceinline__ void ph9_final(Frame& F) {
    const int gw = F.bx * 8 + F.wave, NGW = F.G * 8;
    float* outp = (float*)inp(F, 27);
    for (int tok = gw; tok < NTOK; tok += NGW) final_row(F, outp, tok);
}

constexpr int NPH = 10;
struct Args { const float* in[27]; float* out; unsigned char* ws; int ph_lo, ph_hi; };
__global__ void __launch_bounds__(512, 2) mk_fwd(Args args) {
    extern __shared__ __attribute__((aligned(16))) unsigned char lds[];
    Frame F;
    F.lds = (LAS unsigned char*)lds;
    F.LC = (volatile LAS unsigned*)(F.lds + LDSCTL_OFF);
    F.wave = __builtin_amdgcn_readfirstlane((int)threadIdx.x >> 6); F.lane = lane_id(); F.tid = F.wave * 64 + F.lane;
    F.G = gridDim.x; F.bx = blockIdx.x; F.ws = args.ws; F.rep = 0;
    for (int u = F.tid; u < (LDS_BYTES - LDSCTL_OFF) / 4; u += 512) F.LC[u] = 0u;
    __syncthreads();
    if (F.tid == 27) { const unsigned long long pv = (unsigned long long)args.out; F.LC[LC_PTR + 54] = (unsigned)pv; F.LC[LC_PTR + 55] = (unsigned)(pv >> 32); }
    if (F.tid < 27) { const unsigned long long pv = (unsigned long long)args.in[F.tid]; F.LC[LC_PTR + 2 * F.tid] = (unsigned)pv; F.LC[LC_PTR + 2 * F.tid + 1] = (unsigned)(pv >> 32); }
    __syncthreads();
    const int lo = args.ph_lo, hi = args.ph_hi;
    XcdBarrier bar; bar.bar = (unsigned*)(F.ws + WS_CTL) + CW_BAR; bar.x = 0; bar.st = F.LC + LC_BAR; bar.wave = F.wave;
    if (hi - lo > 1) bar = xcd_barrier_post((unsigned*)(F.ws + WS_CTL) + CW_BAR, F.LC + LC_BAR, F.wave);
#ifndef PH_MASK
#define PH_MASK 0x3ff
#endif
#define IN(k) (((PH_MASK >> (k)) & 1) && lo <= (k) && (k) < hi)
#define SEAM(k) do { if (IN(k) && IN((k) + 1)) xcd_barrier(bar); } while (0)

#define RUN(k, ...) do { if (IN(k)) { F.rep = 0; { int l_ = lane_id(); asm volatile("" : "+v"(l_)); F.lane = l_; F.tid = F.wave * 64 + l_; }     __VA_ARGS__; if (REP_PHASE == (k)) { xcd_barrier(bar); F.rep = 1; __VA_ARGS__; } } } while (0)
    RUN(0, p0_prologue(F));
    SEAM(0);
    RUN(1, ph1_gemms(F));
    SEAM(1);
    RUN(2, ph2_mixers(F));
    SEAM(2);
    RUN(3, ph3_rg_final(F));
    SEAM(3);
    RUN(4, ph4_outproj(F));
    SEAM(4);
    RUN(5, ph5_router(F));
    SEAM(5);
    RUN(6, scatter_phase(F));
    SEAM(6);
    RUN(7, ph7_gateup(F));
    SEAM(7);
    RUN(8, ph8_down(F));
    SEAM(8);
    RUN(9, ph9_final(F));
#undef IN
#undef SEAM
}

extern "C" void kernel_launch(void* const* d_in, const int* in_sizes, int n_in, void* d_out, int out_size, void* d_ws, size_t ws_size, hipStream_t stream) {
    static int grid = 0;
    if (grid == 0) {
        if (n_in != 27 || out_size != NTOK * D || ws_size < WS_END) { fprintf(stderr, "kernel_launch: unexpected shapes (n_in %d, out %d, ws %zu)\n", n_in, out_size, ws_size); grid = -1; return; }
        int dev = 0, cus = 0, per_cu = 0;
        if (hipGetDevice(&dev) != hipSuccess || hipDeviceGetAttribute(&cus, hipDeviceAttributeMultiprocessorCount, dev) != hipSuccess) { grid = -1; return; }
        if (hipFuncSetAttribute((const void*)mk_fwd, hipFuncAttributeMaxDynamicSharedMemorySize, LDS_BYTES) != hipSuccess) { fprintf(stderr, "kernel_launch: hipFuncSetAttribute failed\n"); grid = -1; return; }
        if (hipOccupancyMaxActiveBlocksPerMultiprocessor(&per_cu, (const void*)mk_fwd, 512, LDS_BYTES) != hipSuccess || per_cu < 1) { fprintf(stderr, "kernel_launch: occupancy query says %d\n", per_cu); }
        (void)hipGetLastError();
        grid = cus;
    }
    if (grid < 0) return;
    (void)hipMemsetAsync((char*)d_ws + WS_CTL, 0, CTL_ZERO_BYTES, stream);
    Args a{};
    for (int i = 0; i < 27; ++i) a.in[i] = (const float*)d_in[i];
    a.out = (float*)d_out; a.ws = (unsigned char*)d_ws;
#if MK_ONE_LAUNCH
    a.ph_lo = 0; a.ph_hi = NPH;
    hipLaunchKernelGGL(mk_fwd, dim3(grid), dim3(512), LDS_BYTES, stream, a);
#else
    for (int ph = 0; ph < NPH; ++ph) { a.ph_lo = ph; a.ph_hi = ph + 1; hipLaunchKernelGGL(mk_fwd, dim3(grid), dim3(512), LDS_BYTES, stream, a); }
#endif
}
```
